# Optimizing an MI355X kernel written in HIP

```python
import math
import jax
import jax.numpy as jnp
from jax import lax
import numpy as np

D_MODEL = 2048
BATCH = 4
SEQ = 2048
DEPTH = 1

GRID_W = 64
CTX_LEN = 256
HEAD_DIM = 128
N_Q_HEADS = D_MODEL // HEAD_DIM
N_KV_HEADS = N_Q_HEADS // 4
Q_PER_KV = N_Q_HEADS // N_KV_HEADS
ATTN_W = N_Q_HEADS * HEAD_DIM
KV_W = N_KV_HEADS * HEAD_DIM
ROPE_AXIS_DIM = HEAD_DIM // 2
ROPE_THETA = 10000.0
Q_BLOCK = 128
ATTN_SCALE = HEAD_DIM ** -0.5
SSM_W = D_MODEL // 2
SSM_GROUP = 16
SSM_GROUPS = SSM_W // SSM_GROUP
SSM_STATE = 64
DT_MIN = 1e-3
DT_MAX = 1e-1
D_FF = ((8 * D_MODEL // 3 + 255) // 256) * 256
N_MOD = 9
N_MOD_CTX_LAST = 5
NORM_EPS = 1e-6
CTX_IN_W = 2 * KV_W + SSM_W
IN_W = CTX_IN_W + ATTN_W + 2 * D_MODEL
SPLITS = [KV_W, 2 * KV_W, CTX_IN_W, CTX_IN_W + ATTN_W]

kernel_name = 'hybrid_s5_gqa_macaron_dit_layer'


def _rms_norm(x, g):
    xf = x.astype(jnp.float32)
    xf = xf * lax.rsqrt(jnp.mean(xf * xf, axis=-1, keepdims=True) + NORM_EPS)
    return xf.astype(x.dtype) * g


def _modulate(h, shift, scale):
    return h * (1 + scale) + shift


def _swiglu(h, w_gate, w_up, w_down):
    return (jax.nn.silu(h @ w_gate) * (h @ w_up)) @ w_down


def _axial_rope_tables(L):
    rows = L // GRID_W
    row_ids = jnp.broadcast_to(jnp.arange(rows)[:, None], (rows, GRID_W)).reshape(-1)
    col_ids = jnp.broadcast_to(jnp.arange(GRID_W)[None, :], (rows, GRID_W)).reshape(-1)
    half = ROPE_AXIS_DIM // 2
    inv_freq = ROPE_THETA ** (-jnp.arange(half, dtype=jnp.float32) / half)
    ang_r = row_ids.astype(jnp.float32)[:, None, None] * inv_freq
    ang_c = col_ids.astype(jnp.float32)[:, None, None] * inv_freq
    return (jnp.cos(ang_r), jnp.sin(ang_r), jnp.cos(ang_c), jnp.sin(ang_c))


def _rope_half(x, cos, sin):
    cos = cos.astype(x.dtype)
    sin = sin.astype(x.dtype)
    x1, x2 = jnp.split(x, 2, axis=-1)
    return jnp.concatenate([x1 * cos - x2 * sin, x2 * cos + x1 * sin], axis=-1)


def _axial_rope(x, tables):
    cos_r, sin_r, cos_c, sin_c = tables
    return jnp.concatenate([_rope_half(x[..., :ROPE_AXIS_DIM], cos_r, sin_r),
                            _rope_half(x[..., ROPE_AXIS_DIM:], cos_c, sin_c)], axis=-1)


def _attend_block(qb, k, v):
    B, T = qb.shape[0], qb.shape[1]
    qg = qb.reshape(B, T, N_KV_HEADS, Q_PER_KV, HEAD_DIM)
    s = jnp.einsum('bqkrd,bskd->bkrqs', qg, k).astype(jnp.float32) * ATTN_SCALE
    p = jax.nn.softmax(s, axis=-1).astype(v.dtype)
    o = jnp.einsum('bkrqs,bskd->bqkrd', p, v)
    return o.reshape(B, T, ATTN_W)


def _blocked_attention(q, k, v):
    B, L = q.shape[0], q.shape[1]
    nb = L // Q_BLOCK
    qb = q.reshape(B, nb, Q_BLOCK, N_Q_HEADS, HEAD_DIM).swapaxes(0, 1)
    o = lax.map(lambda qi: _attend_block(qi, k, v), qb)
    return o.swapaxes(0, 1).reshape(B, L, ATTN_W)


def _zoh(a_re, a_im, log_dt):
    a_re = a_re.astype(jnp.float32)
    a_im = a_im.astype(jnp.float32)
    dt = jnp.exp(log_dt.astype(jnp.float32))[:, None]
    mag = jnp.exp(a_re * dt)
    lb_re = mag * jnp.cos(a_im * dt)
    lb_im = mag * jnp.sin(a_im * dt)
    den = a_re * a_re + a_im * a_im
    coef_re = ((lb_re - 1.0) * a_re + lb_im * a_im) / den
    coef_im = (lb_im * a_re - (lb_re - 1.0) * a_im) / den
    return lb_re, lb_im, coef_re, coef_im


def _drive(u, b_re, b_im, coef_re, coef_im):
    bu_re = jnp.einsum('blgc,gpc->blgp', u, b_re)
    bu_im = jnp.einsum('blgc,gpc->blgp', u, b_im)
    return coef_re * bu_re - coef_im * bu_im, coef_re * bu_im + coef_im * bu_re


def _combine(e1, e2):
    a1r, a1i, b1r, b1i = e1
    a2r, a2i, b2r, b2i = e2
    return (a2r * a1r - a2i * a1i,
            a2r * a1i + a2i * a1r,
            a2r * b1r - a2i * b1i + b2r,
            a2r * b1i + a2i * b1r + b2i)


def _scan(lb_re, lb_im, bu_re, bu_im, reverse, h0=None):
    L = bu_re.shape[1]
    a_re = jnp.broadcast_to(lb_re, (1, L) + lb_re.shape)
    a_im = jnp.broadcast_to(lb_im, (1, L) + lb_im.shape)
    A_re, A_im, s_re, s_im = lax.associative_scan(_combine, (a_re, a_im, bu_re, bu_im),
                                                  reverse=reverse, axis=1)
    if h0 is None:
        return s_re, s_im
    h0_re, h0_im = h0
    return (s_re + A_re * h0_re - A_im * h0_im, s_im + A_re * h0_im + A_im * h0_re)


def _readout(h_re, h_im, c_re, c_im):
    return (jnp.einsum('blgp,gcp->blgc', h_re, c_re)
            - jnp.einsum('blgp,gcp->blgc', h_im, c_im))


def _s5_mixer(u, uc, a_re, a_im, log_dt, b_re, b_im, c_re, c_im, d, ctx_out):
    B, L = u.shape[0], u.shape[1]
    Lc = uc.shape[1]
    uf = u.astype(jnp.float32).reshape(B, L, SSM_GROUPS, SSM_GROUP)
    ucf = uc.astype(jnp.float32).reshape(B, Lc, SSM_GROUPS, SSM_GROUP)
    d_g = d.astype(jnp.float32).reshape(SSM_GROUPS, SSM_GROUP)
    y = d_g * uf
    yc = d_g * ucf if ctx_out else None
    for direction, reverse in ((0, False), (1, True)):
        lb_re, lb_im, coef_re, coef_im = _zoh(a_re[direction], a_im[direction], log_dt[direction])
        br = b_re[direction].astype(jnp.float32)
        bi = b_im[direction].astype(jnp.float32)
        cr = c_re[direction].astype(jnp.float32)
        ci = c_im[direction].astype(jnp.float32)
        dc_re, dc_im = _drive(ucf, br, bi, coef_re, coef_im)
        hc_re, hc_im = _scan(lb_re, lb_im, dc_re, dc_im, reverse)
        edge = slice(0, 1) if reverse else slice(Lc - 1, Lc)
        h0 = (hc_re[:, edge], hc_im[:, edge])
        dl_re, dl_im = _drive(uf, br, bi, coef_re, coef_im)
        h_re, h_im = _scan(lb_re, lb_im, dl_re, dl_im, reverse, h0)
        y = y + _readout(h_re, h_im, cr, ci)
        if ctx_out:
            yc = yc + _readout(hc_re, hc_im, cr, ci)
    y = y.reshape(B, L, SSM_W).astype(u.dtype)
    if ctx_out:
        yc = yc.reshape(B, Lc, SSM_W).astype(u.dtype)
    return y, yc


def _merge(attn, ssm, gate, w_glu, b_glu, w_br_attn, w_br_ssm, w_out):
    y = jax.nn.gelu(ssm)
    y = y * jax.nn.sigmoid(y @ w_glu + b_glu)
    g_attn, g_ssm = jnp.split(jax.nn.sigmoid(gate), 2, axis=-1)
    merged = g_attn * (attn @ w_br_attn) + g_ssm * (y @ w_br_ssm)
    return merged @ w_out


def _token_mixer(h, hc, rope, w_in, q_g, k_g, a_re, a_im, log_dt, b_re, b_im, c_re, c_im, d,
                 w_glu, b_glu, w_br_attn, w_br_ssm, w_out, ctx_out):
    B, L = h.shape[0], h.shape[1]
    Lc = hc.shape[1]
    k, v, u, q, gate = jnp.split(h @ w_in, SPLITS, axis=-1)
    pc = hc @ (w_in if ctx_out else w_in[:, :CTX_IN_W])
    kc, vc, uc = pc[..., :KV_W], pc[..., KV_W:2 * KV_W], pc[..., 2 * KV_W:CTX_IN_W]
    q = _axial_rope(_rms_norm(q.reshape(B, L, N_Q_HEADS, HEAD_DIM), q_g), rope)
    k = _axial_rope(_rms_norm(k.reshape(B, L, N_KV_HEADS, HEAD_DIM), k_g), rope)
    kc = _rms_norm(kc.reshape(B, Lc, N_KV_HEADS, HEAD_DIM), k_g)
    vc = vc.reshape(B, Lc, N_KV_HEADS, HEAD_DIM)
    v = v.reshape(B, L, N_KV_HEADS, HEAD_DIM)
    k_all = jnp.concatenate([kc, k], axis=1)
    v_all = jnp.concatenate([vc, v], axis=1)
    attn = _blocked_attention(q, k_all, v_all)
    ssm, ssm_c = _s5_mixer(u, uc, a_re, a_im, log_dt, b_re, b_im, c_re, c_im, d, ctx_out)
    out = _merge(attn, ssm, gate, w_glu, b_glu, w_br_attn, w_br_ssm, w_out)
    out_c = None
    if ctx_out:
        qc = _rms_norm(pc[..., CTX_IN_W:CTX_IN_W + ATTN_W].reshape(B, Lc, N_Q_HEADS, HEAD_DIM), q_g)
        attn_c = _attend_block(qc, kc, vc)
        out_c = _merge(attn_c, ssm_c, pc[..., CTX_IN_W + ATTN_W:], w_glu, b_glu,
                       w_br_attn, w_br_ssm, w_out)
    return out, out_c


def setup_inputs(seed: int = 0) -> dict:
    key = jax.random.key(seed)
    ks = jax.random.split(key, 32)
    f32 = jnp.float32

    def nrm(k, shape, scale):
        return jax.random.normal(k, shape, f32) * scale

    G, P, E = SSM_GROUPS, SSM_STATE, SSM_GROUP
    n_idx = jnp.arange(P, dtype=f32)
    return {
        'x': nrm(ks[0], (BATCH, SEQ, D_MODEL), 1.0),
        'c': nrm(ks[1], (BATCH, D_MODEL), 1.0),
        'ctx': nrm(ks[2], (BATCH, CTX_LEN, D_MODEL), 1.0),
        'c_ctx': nrm(ks[3], (D_MODEL,), 1.0),
        'w_mod': nrm(ks[4], (DEPTH, D_MODEL, N_MOD * D_MODEL), 0.5 * D_MODEL ** -0.5),
        'b_mod': nrm(ks[5], (DEPTH, N_MOD * D_MODEL), 0.01),
        'norm_g': 1.0 + nrm(ks[6], (DEPTH, 3, D_MODEL), 0.02),
        'w_ffn1_gate': nrm(ks[7], (DEPTH, D_MODEL, D_FF), D_MODEL ** -0.5),
        'w_ffn1_up': nrm(ks[8], (DEPTH, D_MODEL, D_FF), D_MODEL ** -0.5),
        'w_ffn1_down': nrm(ks[9], (DEPTH, D_FF, D_MODEL), D_FF ** -0.5),
        'w_in': nrm(ks[10], (DEPTH, D_MODEL, IN_W), D_MODEL ** -0.5),
        'q_norm_g': 1.0 + nrm(ks[11], (DEPTH, HEAD_DIM), 0.02),
        'k_norm_g': 1.0 + nrm(ks[12], (DEPTH, HEAD_DIM), 0.02),
        'ssm_a_re': -0.5 + nrm(ks[13], (DEPTH, 2, G, P), 0.01),
        'ssm_a_im': math.pi * n_idx + nrm(ks[14], (DEPTH, 2, G, P), 0.01),
        'ssm_log_dt': jax.random.uniform(ks[15], (DEPTH, 2, G), f32,
                                         math.log(DT_MIN), math.log(DT_MAX)),
        'ssm_b_re': nrm(ks[16], (DEPTH, 2, G, P, E), (2 * E) ** -0.5),
        'ssm_b_im': nrm(ks[17], (DEPTH, 2, G, P, E), (2 * E) ** -0.5),
        'ssm_c_re': nrm(ks[18], (DEPTH, 2, G, E, P), P ** -0.5),
        'ssm_c_im': nrm(ks[19], (DEPTH, 2, G, E, P), P ** -0.5),
        'ssm_d': nrm(ks[20], (DEPTH, SSM_W), 1.0),
        'w_glu': nrm(ks[21], (DEPTH, SSM_W, SSM_W), SSM_W ** -0.5),
        'b_glu': nrm(ks[22], (DEPTH, SSM_W), 0.01),
        'w_br_attn': nrm(ks[23], (DEPTH, ATTN_W, D_MODEL), ATTN_W ** -0.5),
        'w_br_ssm': nrm(ks[24], (DEPTH, SSM_W, D_MODEL), SSM_W ** -0.5),
        'w_out': nrm(ks[25], (DEPTH, D_MODEL, D_MODEL), D_MODEL ** -0.5),
        'w_ffn2_gate': nrm(ks[26], (DEPTH, D_MODEL, D_FF), D_MODEL ** -0.5),
        'w_ffn2_up': nrm(ks[27], (DEPTH, D_MODEL, D_FF), D_MODEL ** -0.5),
        'w_ffn2_down': nrm(ks[28], (DEPTH, D_FF, D_MODEL), D_FF ** -0.5),
    }


def reference(x, c, ctx, c_ctx, w_mod, b_mod, norm_g, w_ffn1_gate, w_ffn1_up, w_ffn1_down,
              w_in, q_norm_g, k_norm_g, ssm_a_re, ssm_a_im, ssm_log_dt, ssm_b_re, ssm_b_im,
              ssm_c_re, ssm_c_im, ssm_d, w_glu, b_glu, w_br_attn, w_br_ssm, w_out,
              w_ffn2_gate, w_ffn2_up, w_ffn2_down):
    L = x.shape[1]
    rope = _axial_rope_tables(L)
    silu_c = jax.nn.silu(c)
    silu_cc = jax.nn.silu(c_ctx)
    for l in range(DEPTH):
        last = l == DEPTH - 1
        n_ctx_mod = N_MOD_CTX_LAST if last else N_MOD
        mod = (silu_c @ w_mod[l] + b_mod[l])[:, None, :]
        sh1, sc1, g1, sh2, sc2, g2, sh3, sc3, g3 = jnp.split(mod, N_MOD, axis=-1)
        mod_c = silu_cc @ w_mod[l][:, :n_ctx_mod * D_MODEL] + b_mod[l][:n_ctx_mod * D_MODEL]
        mc = jnp.split(mod_c, n_ctx_mod, axis=-1)
        ffn1 = (w_ffn1_gate[l], w_ffn1_up[l], w_ffn1_down[l])
        ffn2 = (w_ffn2_gate[l], w_ffn2_up[l], w_ffn2_down[l])
        x = x + 0.5 * g1 * _swiglu(_modulate(_rms_norm(x, norm_g[l, 0]), sh1, sc1), *ffn1)
        ctx = ctx + 0.5 * mc[2] * _swiglu(_modulate(_rms_norm(ctx, norm_g[l, 0]), mc[0], mc[1]), *ffn1)
        h = _modulate(_rms_norm(x, norm_g[l, 1]), sh2, sc2)
        hc = _modulate(_rms_norm(ctx, norm_g[l, 1]), mc[3], mc[4])
        mix, mix_c = _token_mixer(h, hc, rope, w_in[l], q_norm_g[l], k_norm_g[l],
                                  ssm_a_re[l], ssm_a_im[l], ssm_log_dt[l], ssm_b_re[l], ssm_b_im[l],
                                  ssm_c_re[l], ssm_c_im[l], ssm_d[l], w_glu[l], b_glu[l],
                                  w_br_attn[l], w_br_ssm[l], w_out[l], not last)
        x = x + g2 * mix
        x = x + 0.5 * g3 * _swiglu(_modulate(_rms_norm(x, norm_g[l, 2]), sh3, sc3), *ffn2)
        if not last:
            ctx = ctx + mc[5] * mix_c
            ctx = ctx + 0.5 * mc[8] * _swiglu(_modulate(_rms_norm(ctx, norm_g[l, 2]), mc[6], mc[7]), *ffn2)
    return x
```

```cpp
#include <hip/hip_runtime.h>
#include <hip/hip_cooperative_groups.h>
#include <cstdio>
#include <cstdint>
namespace cg = cooperative_groups;

#ifndef MK_COOP
#define MK_COOP 1
#endif

#define LAS __attribute__((address_space(3)))
typedef unsigned short bf16_t;
typedef short bf16x8 __attribute__((ext_vector_type(8)));
typedef short s16x4 __attribute__((ext_vector_type(4)));
typedef float f32x4 __attribute__((ext_vector_type(4)));
typedef float f32x2 __attribute__((ext_vector_type(2)));
typedef float f32x16 __attribute__((ext_vector_type(16)));
typedef unsigned u32x4 __attribute__((ext_vector_type(4)));
typedef unsigned u32x2 __attribute__((ext_vector_type(2)));

constexpr int DM = 2048, NB = 4, SEQ = 2048, LC = 256, ML = NB * SEQ  , MC = NB * LC  , MT = ML + MC  ;
constexpr int DFF = 5632, INW = 8192, SKV = SEQ + LC  , NMOD = 9 * DM  , SSMW = 1024;
constexpr int NCH = SKV / 16  , SROWS = NB * NCH  , SROWS_PAD = 768;
constexpr float EPS = 1e-6f;

constexpr size_t al256(size_t x) { return (x + 255) / 256 * 256; }
constexpr size_t WS_W1GU = 0;
constexpr size_t WS_W1D  = WS_W1GU + al256((size_t)2 * DFF * DM * 2);
constexpr size_t WS_WIN  = WS_W1D + al256((size_t)DM * DFF * 2);
constexpr size_t WS_WGLU = WS_WIN + al256((size_t)INW * DM * 2);
constexpr size_t WS_WBRA = WS_WGLU + al256((size_t)SSMW * SSMW * 2);
constexpr size_t WS_WBRS = WS_WBRA + al256((size_t)DM * DM * 2);
constexpr size_t WS_WOUT = WS_WBRS + al256((size_t)DM * SSMW * 2);
constexpr size_t WS_W2GU = WS_WOUT + al256((size_t)DM * DM * 2);
constexpr size_t WS_W2D  = WS_W2GU + al256((size_t)2 * DFF * DM * 2);
constexpr size_t WS_MOD  = WS_W2D + al256((size_t)DM * DFF * 2);
constexpr size_t WS_H    = WS_MOD + al256((size_t)5 * NMOD * 4);
constexpr size_t WS_ACT  = WS_H + al256((size_t)MT * DM * 2);
constexpr size_t WS_X1   = WS_ACT + al256((size_t)MT * DFF * 2);
constexpr size_t WS_Q    = WS_X1 + al256((size_t)MT * DM * 4);
constexpr size_t WS_K    = WS_Q + al256((size_t)ML * DM * 2);
constexpr size_t WS_V    = WS_K + al256((size_t)NB * SKV * 512 * 2);
constexpr size_t WS_A2   = WS_V + al256((size_t)NB * SKV * 512 * 2);
constexpr size_t WS_S    = WS_A2 + al256((size_t)64 * SROWS_PAD * 512 * 2);
constexpr size_t WS_WY   = WS_S + al256((size_t)64 * SROWS * 256 * 4);
constexpr size_t WS_WST  = WS_WY + al256((size_t)64 * 256 * 512 * 2);
constexpr size_t WS_BAR  = WS_WST + al256((size_t)64 * 256 * 256 * 2);
constexpr size_t WS_END  = WS_BAR + al256((size_t)3456 * 4);
constexpr size_t WS_AY   = WS_H;
constexpr size_t WS_GATE = WS_ACT + 19922944;
constexpr size_t WS_YG   = WS_GATE + (size_t)ML * 4096 * 2;
static_assert(WS_YG + (size_t)ML * SSMW * 2 <= WS_X1 && WS_AY + (size_t)ML * 3072 * 2 <= WS_GATE && WS_GATE % 256 == 0, "ACT aliases");
constexpr int LDAY = 3072;
constexpr size_t WS_MERGED = WS_Q;

constexpr int LDS_BYTES = 131072 + 16;
constexpr int LDS_XB_OFF = 131072;

typedef __bf16 bf16v2_t __attribute__((ext_vector_type(2)));
__device__ __forceinline__ unsigned cvt_pk_bf16(float lo, float hi) { const f32x2 v = (f32x2){lo, hi}; const bf16v2_t b = __builtin_convertvector(v, bf16v2_t); return __builtin_bit_cast(unsigned, b); }
__device__ __forceinline__ float bf_lo(unsigned w) { return __uint_as_float(w << 16); }
__device__ __forceinline__ float bf_hi(unsigned w) { return __uint_as_float(w & 0xffff0000u); }
__device__ __forceinline__ float wave_sum(float v) {
#pragma unroll
    for (int o = 1; o < 64; o <<= 1) v += __shfl_xor(v, o);
    return v;
}
__device__ __forceinline__ float sigmoid_f(float x) { return __builtin_amdgcn_rcpf(1.f + __builtin_amdgcn_exp2f(-1.4426950408889634f * x)); }
__device__ __forceinline__ float silu_f(float x) { return x * __builtin_amdgcn_rcpf(1.f + __builtin_amdgcn_exp2f(-1.4426950408889634f * x)); }
__device__ __forceinline__ float gelu_tanh_f(float x) { const float u = 0.7978845608028654f * (x + 0.044715f * x * x * x); return x * __builtin_amdgcn_rcpf(1.f + __builtin_amdgcn_exp2f(-2.8853900817779268f * u)); }
__device__ __forceinline__ f32x2 cmul(f32x2 a, f32x2 b) { return (f32x2){a.x * b.x - a.y * b.y, a.x * b.y + a.y * b.x}; }
#define LDS_WAIT() asm volatile("s_waitcnt lgkmcnt(0)" ::: "memory")

namespace pg8 {
constexpr int BM = 256, BK = 64, HALF = 128, HTB = HALF * BK * 2, STAGE_BYTES = 8 * HTB, NXCD = 8, WGM = 4;
__host__ __device__ __forceinline__ int lds_byte(int r, int c) { const int st = (r >> 4) * 2 + (c >> 5), rr = r & 15, cc = c & 31, ob = rr * 64 + cc * 2; return st * 1024 + (ob ^ (((ob >> 9) & 1) << 5)); }
__host__ __device__ __forceinline__ void stage_rc(int b, int& R, int& C) { const int st = b / 1024, sb = b % 1024, swz = sb ^ (((sb >> 9) & 1) << 5); R = (st >> 1) * 16 + swz / 64; C = (st & 1) * 32 + (swz % 64) / 2; }
__host__ __device__ __forceinline__ int perm32(int rho) { const int n = rho >> 4, i = rho & 15; return 8 * (i >> 2) + 4 * n + (i & 3); }

struct Unit { int pm, pn, ko; };
struct Gemm { const bf16_t* A; const bf16_t* Bt; int lda, ldb, K; };

struct RectOrder {
    int nM, nN, nwg, G, c, pm0, pn0, rep = 1;
    __device__ void init(int nM_, int nN_, int G_, int c_, int pm0_ = 0, int pn0_ = 0) { nM = nM_; nN = nN_; nwg = nM * nN; G = G_; c = c_; pm0 = pm0_; pn0 = pn0_; }
    __device__ bool map(long L, Unit& u) const {
        if (L >= (long)nwg * rep) return false;
        int wgid = (int)(L % nwg); { const int q = nwg / NXCD, r = nwg % NXCD, xcd = wgid % NXCD, off = wgid / NXCD; wgid = (xcd < r ? xcd * (q + 1) : r * (q + 1) + (xcd - r) * q) + off; }
        const int nig = WGM * nN, gid = wgid / nig, fm = gid * WGM, gsz = (nM - fm) < WGM ? (nM - fm) : WGM;
        u.pm = pm0 + fm + ((wgid % nig) % gsz); u.pn = pn0 + (wgid % nig) / gsz; u.ko = 0; return true;
    }
    __device__ bool next(int i, Unit& u) const { return map((long)i * G + c, u); }
};
struct InProjOrder {
    RectOrder r0; int G, c;
    __device__ bool next(int i, Unit& u) const {
        const long L = (long)i * G + c;
        if (L < r0.nwg) return r0.map(L, u);
        const int l2 = (int)(L - r0.nwg); if (l2 >= 32) return false;
        u.pm = 32 + (l2 & 3); u.pn = l2 >> 2; u.ko = 0; return true;
    }
};
struct BatchOrder {
    int G, c;
    __device__ bool next(int i, Unit& u) const { const long L = (long)i * G + c; if (L >= 192) return false; u.pm = (int)L; u.pn = (int)L / 3; u.ko = 0; return true; }
};

struct CtxSplitOrder {
    int G, c;
    __device__ bool next(int i, Unit& u) const { const long L = (long)i * G + c; if (L >= 128) return false; u.pm = (int)L & 3; u.pn = ((int)L >> 2) & 7; u.ko = ((int)L >> 5) * (1408 * 2); return true; }
};

struct MergeOrder {
    RectOrder r;
    __device__ bool next(int i, Unit& u) const { if (!r.map((long)(i >> 1) * r.G + r.c, u)) return false; u.ko = (i & 1) ? 2048 * 2 : 0; return true; }
};

template <class Epi, class Sched>
__device__ __forceinline__ void gemm_phase(LAS unsigned char* lds, const Gemm g, const Sched& S, const Epi& E) {
    const int tid = threadIdx.x, wid = __builtin_amdgcn_readfirstlane(tid >> 6), lane = tid & 63, wr = wid >> 2, wc = wid & 3, fr = lane & 15, fq = lane >> 4;
    const int K = g.K, nt = K / BK, lda = g.lda, ldb = g.ldb;
    unsigned voffA[2], voffB[2];
#pragma unroll
    for (int i = 0; i < 2; ++i) { int R, C; stage_rc(tid * 16 + i * 8192, R, C); const int Rb = Epi::PERM ? ((R & ~31) + perm32(R & 31)) : R;
        voffA[i] = (unsigned)(R * lda + C) * 2u; voffB[i] = (unsigned)(Rb * ldb + C) * 2u; }
    const size_t kstep = (size_t)(BK * 2);
    const size_t hstepA = (size_t)HALF * lda * 2, hstepB = (size_t)HALF * ldb * 2;
    const size_t tstepA = 2 * hstepA, tstepB = 2 * hstepB;
    const unsigned ldsw = (unsigned)wid * 1024u;
    const int aoff = lds_byte(wr * 64 + fr, fq * 8), boff = lds_byte(wc * 32 + fr, fq * 8);
#define PG8_SA(b, h) (((b) * 2 + (h)) * HTB)
#define PG8_SB(b, h) ((4 + (b) * 2 + (h)) * HTB)
#define PG8_STAGE(bufoff, gbase, voff) do { _Pragma("unroll") for (int _i = 0; _i < 2; ++_i) \
        __builtin_amdgcn_global_load_lds((const unsigned*)((const char*)(gbase) + (voff)[_i]), (LAS unsigned*)(lds + (bufoff) + ldsw + _i * 8192), 16, 0, 0); } while (0)
#define PG8_LDA(dst, b, h) do { _Pragma("unroll") for (int m = 0; m < 4; ++m) _Pragma("unroll") for (int k = 0; k < 2; ++k) dst[m][k] = *(const LAS bf16x8*)(lds + PG8_SA(b, h) + aoff + m * 2048 + k * 1024); } while (0)
#define PG8_LDB(dst, b, h) do { _Pragma("unroll") for (int n = 0; n < 2; ++n) _Pragma("unroll") for (int k = 0; k < 2; ++k) dst[n][k] = *(const LAS bf16x8*)(lds + PG8_SB(b, h) + boff + n * 2048 + k * 1024); } while (0)
#define PG8_MMA(ai, bj, At, Bt) do { __builtin_amdgcn_s_setprio(1); _Pragma("unroll") for (int m = 0; m < 4; ++m) _Pragma("unroll") for (int n = 0; n < 2; ++n) _Pragma("unroll") for (int k = 0; k < 2; ++k) \
        acc[ai][bj][m][n] = __builtin_amdgcn_mfma_f32_16x16x32_bf16(Bt[n][k], At[m][k], acc[ai][bj][m][n], 0, 0, 0); __builtin_amdgcn_s_setprio(0); } while (0)
#define PG8_WAIT_V(n) asm volatile("s_waitcnt vmcnt(" #n ")" ::: "memory")
#define PG8_WAIT_L(n) asm volatile("s_waitcnt lgkmcnt(" #n ")" ::: "memory")
#define PG8_BAR __builtin_amdgcn_s_barrier()
#define PG8_SCHED __builtin_amdgcn_sched_barrier(0)
    Unit cur, nxt; int ui = 0;
    if (!S.next(0, cur)) return;
    f32x4 acc[2][2][4][2];
#pragma unroll
    for (int a = 0; a < 2; ++a)
#pragma unroll
        for (int b = 0; b < 2; ++b)
#pragma unroll
            for (int m = 0; m < 4; ++m)
#pragma unroll
                for (int n = 0; n < 2; ++n) acc[a][b][m][n] = (f32x4){0.f, 0.f, 0.f, 0.f};
    bf16x8 At[4][2], B0[2][2], B1[2][2];
    const char* cA = (const char*)g.A + (size_t)cur.pm * tstepA + cur.ko; const char* cB = (const char*)g.Bt + (size_t)cur.pn * tstepB + cur.ko;
    PG8_STAGE(PG8_SB(0, 0), cB, voffB); PG8_STAGE(PG8_SB(0, 1), cB + hstepB, voffB); PG8_STAGE(PG8_SA(0, 0), cA, voffA); PG8_STAGE(PG8_SA(0, 1), cA + hstepA, voffA);
    if (wr == 1) PG8_BAR;
    PG8_WAIT_V(2); PG8_BAR;
    PG8_STAGE(PG8_SB(1, 0), cB + kstep, voffB); PG8_STAGE(PG8_SA(1, 0), cA + kstep, voffA); PG8_STAGE(PG8_SB(1, 1), cB + hstepB + kstep, voffB);
    PG8_WAIT_V(6); PG8_BAR;
    for (;;) {
        const bool has_next = S.next(ui + 1, nxt);
        const char* nA = has_next ? (const char*)g.A + (size_t)nxt.pm * tstepA + nxt.ko : cA; const char* nB = has_next ? (const char*)g.Bt + (size_t)nxt.pn * tstepB + nxt.ko : cB;
#define PG8_ITER \
            const bool last = (t == nt_u - 2); \
            const char* a1 = cA + (size_t)(t + 1) * kstep; \
            const char* a2 = last ? nA : cA + (size_t)(t + 2) * kstep; const char* b2 = last ? nB : cB + (size_t)(t + 2) * kstep; \
            const char* a3 = a2 + kstep; const char* b3 = b2 + kstep; \
            PG8_LDB(B0, 0, 0); PG8_LDB(B1, 0, 1); PG8_SCHED; PG8_LDA(At, 0, 0); PG8_STAGE(PG8_SA(1, 1), a1 + hstepA, voffA); \
            PG8_WAIT_V(8); PG8_WAIT_L(0); PG8_BAR; PG8_MMA(0, 0, At, B0); PG8_MMA(0, 1, At, B1); PG8_BAR; PG8_SCHED; \
            PG8_LDA(At, 0, 1); PG8_STAGE(PG8_SB(0, 0), b2, voffB); PG8_STAGE(PG8_SB(0, 1), b2 + hstepB, voffB); PG8_STAGE(PG8_SA(0, 0), a2, voffA); \
            PG8_WAIT_V(8); PG8_WAIT_L(0); PG8_BAR; PG8_MMA(1, 0, At, B0); PG8_MMA(1, 1, At, B1); PG8_BAR; PG8_SCHED; \
            PG8_LDB(B0, 1, 0); PG8_LDB(B1, 1, 1); PG8_SCHED; PG8_LDA(At, 1, 0); PG8_STAGE(PG8_SA(0, 1), a2 + hstepA, voffA); \
            PG8_WAIT_V(8); PG8_WAIT_L(0); PG8_BAR; PG8_MMA(0, 0, At, B0); PG8_MMA(0, 1, At, B1); PG8_BAR; PG8_SCHED; \
            PG8_LDA(At, 1, 1); PG8_STAGE(PG8_SB(1, 0), b3, voffB); PG8_STAGE(PG8_SB(1, 1), b3 + hstepB, voffB); PG8_STAGE(PG8_SA(1, 0), a3, voffA); \
            PG8_WAIT_V(8); PG8_WAIT_L(0); PG8_BAR; PG8_MMA(1, 0, At, B0); PG8_MMA(1, 1, At, B1); PG8_BAR; PG8_SCHED;
        const int nt_u = (Epi::MID_T >= 0) ? (cur.ko == 0 ? Epi::MID_T : nt - Epi::MID_T) : nt;
        for (int t = 0; t < nt_u; t += 2) { PG8_ITER }
#undef PG8_ITER
        if (wr == 0) PG8_BAR;
        bool keep_acc = false;
        if constexpr (Epi::MID_T >= 0) { if (cur.ko == 0) { E.mid(acc, cur, wr, wc, fr, fq); keep_acc = true; } else E(acc, cur, wr, wc, fr, fq); }
        else E(acc, cur, wr, wc, fr, fq);
        if (!has_next) break;
        if (!keep_acc) {
#pragma unroll
        for (int a = 0; a < 2; ++a)
#pragma unroll
            for (int b = 0; b < 2; ++b)
#pragma unroll
                for (int m = 0; m < 4; ++m)
#pragma unroll
                    for (int n = 0; n < 2; ++n) acc[a][b][m][n] = (f32x4){0.f, 0.f, 0.f, 0.f};
        }
        cur = nxt; cA = nA; cB = nB; ++ui;
        if (wr == 1) PG8_BAR;
    }
    PG8_WAIT_V(0);
    PG8_BAR;
#undef PG8_SA
#undef PG8_SB
#undef PG8_STAGE
#undef PG8_LDA
#undef PG8_LDB
#undef PG8_MMA
#undef PG8_WAIT_V
#undef PG8_WAIT_L
#undef PG8_BAR
#undef PG8_SCHED
}

typedef f32x4 AccT[2][2][4][2];

struct EpiSwiGLU {
    static constexpr bool PERM = true; static constexpr int MID_T = -1;
    bf16_t* O;
    __device__ __forceinline__ void operator()(const AccT& acc, const Unit& u, int wr, int wc, int fr, int fq) const {
        const int row0 = u.pm * BM + wr * 64 + fr, col0 = u.pn * 128 + wc * 32 + 8 * fq;
#pragma unroll
        for (int ai = 0; ai < 2; ++ai)
#pragma unroll
            for (int m = 0; m < 4; ++m) {
                const f32x4 g0 = acc[ai][0][m][0], g1 = acc[ai][0][m][1], u0 = acc[ai][1][m][0], u1 = acc[ai][1][m][1];
                u32x4 w;
                w.x = cvt_pk_bf16(silu_f(g0[0]) * u0[0], silu_f(g0[1]) * u0[1]); w.y = cvt_pk_bf16(silu_f(g0[2]) * u0[2], silu_f(g0[3]) * u0[3]);
                w.z = cvt_pk_bf16(silu_f(g1[0]) * u1[0], silu_f(g1[1]) * u1[1]); w.w = cvt_pk_bf16(silu_f(g1[2]) * u1[2], silu_f(g1[3]) * u1[3]);
                *(u32x4*)(O + (size_t)(row0 + ai * HALF + m * 16) * DFF + col0) = w;
            }
    }
};
struct EpiRes {
    static constexpr bool PERM = false; static constexpr int MID_T = -1;
    const float* res_lat; const float* res_ctx; float* out; const float* mod; int goff; float s;
    __device__ __forceinline__ void operator()(const AccT& acc, const Unit& u, int wr, int wc, int fr, int fq) const {
        const int row0 = u.pm * BM + wr * 64 + fr, col0 = u.pn * BM + wc * 32 + 4 * fq;
        const bool isctx = (u.pm >= ML / BM);
        const int modrow = isctx ? 4 : (u.pm >> 3);
        const float* mg = mod + (size_t)modrow * NMOD + goff + col0;
        f32x4 gv[2][2];
#pragma unroll
        for (int bj = 0; bj < 2; ++bj)
#pragma unroll
            for (int n = 0; n < 2; ++n) gv[bj][n] = *(const f32x4*)(mg + bj * HALF + n * 16) * s;
#pragma unroll
        for (int ai = 0; ai < 2; ++ai) {
            f32x4 r[4][2][2];
#pragma unroll
            for (int m = 0; m < 4; ++m) {
                const int row = row0 + ai * HALF + m * 16;
                const float* rp = (isctx ? res_ctx + (size_t)(row - ML) * DM : res_lat + (size_t)row * DM) + col0;
#pragma unroll
                for (int bj = 0; bj < 2; ++bj)
#pragma unroll
                    for (int n = 0; n < 2; ++n) r[m][bj][n] = *(const f32x4*)(rp + bj * HALF + n * 16);
            }
#pragma unroll
            for (int m = 0; m < 4; ++m) {
                float* op = out + (size_t)(row0 + ai * HALF + m * 16) * DM + col0;
#pragma unroll
                for (int bj = 0; bj < 2; ++bj)
#pragma unroll
                    for (int n = 0; n < 2; ++n) *(f32x4*)(op + bj * HALF + n * 16) = r[m][bj][n] + gv[bj][n] * acc[ai][bj][m][n];
            }
        }
    }
};
template <bool ADD> struct EpiDelta {
    static constexpr bool PERM = true; static constexpr int MID_T = -1;
    const bf16_t* Din; bf16_t* Dout; const float* mod; int goff; float s;
    __device__ __forceinline__ void operator()(const AccT& acc, const Unit& u, int wr, int wc, int fr, int fq) const {
        const int row0 = u.pm * BM + wr * 64 + fr, col0 = u.pn * BM + wc * 32 + 8 * fq;
        const float* mg = mod + (size_t)(u.pm >> 3) * NMOD + goff + col0;
        f32x4 gv[2][2];
#pragma unroll
        for (int bj = 0; bj < 2; ++bj)
#pragma unroll
            for (int n = 0; n < 2; ++n) gv[bj][n] = *(const f32x4*)(mg + bj * HALF + 4 * n) * s;
#pragma unroll
        for (int ai = 0; ai < 2; ++ai) {
            u32x4 din[4][2];
            if (ADD) {
#pragma unroll
                for (int m = 0; m < 4; ++m)
#pragma unroll
                    for (int bj = 0; bj < 2; ++bj) din[m][bj] = *(const u32x4*)(Din + (size_t)(row0 + ai * HALF + m * 16) * DM + col0 + bj * HALF);
            }
#pragma unroll
            for (int m = 0; m < 4; ++m)
#pragma unroll
                for (int bj = 0; bj < 2; ++bj) {
                    f32x4 v0 = gv[bj][0] * acc[ai][bj][m][0], v1 = gv[bj][1] * acc[ai][bj][m][1];
                    if (ADD) { const u32x4 d = din[m][bj]; v0 += (f32x4){bf_lo(d.x), bf_hi(d.x), bf_lo(d.y), bf_hi(d.y)}; v1 += (f32x4){bf_lo(d.z), bf_hi(d.z), bf_lo(d.w), bf_hi(d.w)}; }
                    u32x4 w; w.x = cvt_pk_bf16(v0[0], v0[1]); w.y = cvt_pk_bf16(v0[2], v0[3]); w.z = cvt_pk_bf16(v1[0], v1[1]); w.w = cvt_pk_bf16(v1[2], v1[3]);
                    *(u32x4*)(Dout + (size_t)(row0 + ai * HALF + m * 16) * DM + col0 + bj * HALF) = w;
                }
        }
    }
};
struct EpiFinal {
    static constexpr bool PERM = false; static constexpr int MID_T = -1;
    const float* x; const bf16_t* D; float* out; const float* mod; int goff; float s;
    __device__ __forceinline__ void operator()(const AccT& acc, const Unit& u, int wr, int wc, int fr, int fq) const {
        const int row0 = u.pm * BM + wr * 64 + fr, col0 = u.pn * BM + wc * 32 + 4 * fq;
        const float* mg = mod + (size_t)(u.pm >> 3) * NMOD + goff + col0;
        f32x4 gv[2][2];
#pragma unroll
        for (int bj = 0; bj < 2; ++bj)
#pragma unroll
            for (int n = 0; n < 2; ++n) gv[bj][n] = *(const f32x4*)(mg + bj * HALF + n * 16) * s;
#pragma unroll
        for (int ai = 0; ai < 2; ++ai)
#pragma unroll
            for (int mh = 0; mh < 2; ++mh) {
                f32x4 r[2][2][2]; u32x2 d[2][2][2];
#pragma unroll
                for (int mm = 0; mm < 2; ++mm)
#pragma unroll
                    for (int bj = 0; bj < 2; ++bj)
#pragma unroll
                        for (int n = 0; n < 2; ++n) { const size_t off = (size_t)(row0 + ai * HALF + (mh * 2 + mm) * 16) * DM + col0 + bj * HALF + n * 16;
                            r[mm][bj][n] = __builtin_nontemporal_load((const f32x4*)(x + off)); d[mm][bj][n] = *(const u32x2*)(D + off); }
#pragma unroll
                for (int mm = 0; mm < 2; ++mm)
#pragma unroll
                    for (int bj = 0; bj < 2; ++bj)
#pragma unroll
                        for (int n = 0; n < 2; ++n) { const size_t off = (size_t)(row0 + ai * HALF + (mh * 2 + mm) * 16) * DM + col0 + bj * HALF + n * 16;
                            const u32x2 dd = d[mm][bj][n];
                            *(f32x4*)(out + off) = r[mm][bj][n] + (f32x4){bf_lo(dd.x), bf_hi(dd.x), bf_lo(dd.y), bf_hi(dd.y)} + gv[bj][n] * acc[ai][bj][mh * 2 + mm][n]; }
            }
    }
};
struct EpiNull {
    static constexpr bool PERM = true; static constexpr int MID_T = -1;
    float* dummy;
    __device__ __forceinline__ void operator()(const AccT& acc, const Unit& u, int wr, int wc, int fr, int fq) const {
        f32x4 s = (f32x4){0.f, 0.f, 0.f, 0.f};
#pragma unroll
        for (int ai = 0; ai < 2; ++ai)
#pragma unroll
            for (int bj = 0; bj < 2; ++bj)
#pragma unroll
                for (int m = 0; m < 4; ++m)
#pragma unroll
                    for (int n = 0; n < 2; ++n) s += acc[ai][bj][m][n];
        if (s[0] + s[1] + s[2] + s[3] == 123456.78125f) dummy[u.pm] = s[0];
    }
};
struct EpiPartial {
    static constexpr bool PERM = false; static constexpr int MID_T = -1;
    float* P;
    __device__ __forceinline__ void operator()(const AccT& acc, const Unit& u, int wr, int wc, int fr, int fq) const {
        const int row0 = u.pm * BM + wr * 64 + fr, col0 = u.pn * BM + wc * 32 + 4 * fq;
        float* base = P + (size_t)(u.ko / (1408 * 2)) * MC * DM;
#pragma unroll
        for (int ai = 0; ai < 2; ++ai)
#pragma unroll
            for (int m = 0; m < 4; ++m) { float* op = base + (size_t)(row0 + ai * HALF + m * 16) * DM + col0;
#pragma unroll
                for (int bj = 0; bj < 2; ++bj)
#pragma unroll
                    for (int n = 0; n < 2; ++n) *(f32x4*)(op + bj * HALF + n * 16) = acc[ai][bj][m][n]; }
    }
};
struct EpiInProj {
    static constexpr bool PERM = true; static constexpr int MID_T = -1;
    bf16_t *Kb, *Vb, *A2, *Qb, *GATE;
    template <int TYPE> __device__ __forceinline__ void run(const AccT& acc, const Unit& u, int wr, int wc, int fr, int fq) const {
        const int row0 = u.pm * BM + wr * 64 + fr, colt = u.pn * BM + wc * 32 + 8 * fq;
        const bool isctx = (u.pm >= ML / BM);
#pragma unroll
        for (int ai = 0; ai < 2; ++ai)
#pragma unroll
            for (int m = 0; m < 4; ++m) {
                const int row = row0 + ai * HALF + m * 16;
                int b, pos;
                if (isctx) { const int r = row - ML; b = r >> 8; pos = r & 255; } else { b = row >> 11; pos = 256 + (row & 2047); }
#pragma unroll
                for (int bj = 0; bj < 2; ++bj) {
                    const int col = colt + bj * HALF;
                    f32x4 v0 = acc[ai][bj][m][0], v1 = acc[ai][bj][m][1];
                    bf16_t* dst;
                    if (TYPE == 0) dst = Kb + ((size_t)(b * SKV + pos) * 512 + col);
                    else if (TYPE == 1) dst = Vb + ((size_t)(b * SKV + pos) * 512 + (col - 512));
                    else if (TYPE == 2) { const int cc = col - 1024, grp = cc >> 4, c = cc & 15; dst = A2 + (((size_t)grp * SROWS_PAD + b * NCH + (pos >> 4)) * 512 + (pos & 15) * 16 + c); }
                    else if (TYPE == 3) dst = Qb + ((size_t)row * DM + (col - 2048));
                    else { dst = GATE + ((size_t)row * 4096 + (col - 4096));
#pragma unroll
                        for (int j = 0; j < 4; ++j) { v0[j] = sigmoid_f(v0[j]); v1[j] = sigmoid_f(v1[j]); } }
                    u32x4 w; w.x = cvt_pk_bf16(v0[0], v0[1]); w.y = cvt_pk_bf16(v0[2], v0[3]); w.z = cvt_pk_bf16(v1[0], v1[1]); w.w = cvt_pk_bf16(v1[2], v1[3]);
                    *(u32x4*)dst = w;
                }
            }
    }
    __device__ __forceinline__ void operator()(const AccT& acc, const Unit& u, int wr, int wc, int fr, int fq) const {
        if (u.pn < 2) run<0>(acc, u, wr, wc, fr, fq);
        else if (u.pn < 4) run<1>(acc, u, wr, wc, fr, fq);
        else if (u.pn < 8) run<2>(acc, u, wr, wc, fr, fq);
        else if (u.pn < 16) run<3>(acc, u, wr, wc, fr, fq);
        else run<4>(acc, u, wr, wc, fr, fq);
    }
};
struct EpiState {
    static constexpr bool PERM = false; static constexpr int MID_T = -1;
    float* S;
    __device__ __forceinline__ void operator()(const AccT& acc, const Unit& u, int wr, int wc, int fr, int fq) const {
        const int grp = u.pn, R0 = (u.pm - grp * 3) * BM + wr * 64 + fr, col0 = wc * 32 + 4 * fq;
#pragma unroll
        for (int ai = 0; ai < 2; ++ai)
#pragma unroll
            for (int m = 0; m < 4; ++m) {
                const int R = R0 + ai * HALF + m * 16;
                if (R < SROWS) { float* op = S + ((size_t)grp * SROWS + R) * 256 + col0;
#pragma unroll
                    for (int bj = 0; bj < 2; ++bj)
#pragma unroll
                        for (int n = 0; n < 2; ++n) *(f32x4*)(op + bj * HALF + n * 16) = acc[ai][bj][m][n]; }
            }
    }
};
struct EpiSsmOut {
    static constexpr bool PERM = true; static constexpr int MID_T = -1;
    bf16_t* YG;
    __device__ __forceinline__ void operator()(const AccT& acc, const Unit& u, int wr, int wc, int fr, int fq) const {
        const int grp = u.pn, R0 = (u.pm - grp * 3) * BM + wr * 64 + fr, n0 = wc * 32 + 8 * fq;
#pragma unroll
        for (int ai = 0; ai < 2; ++ai)
#pragma unroll
            for (int m = 0; m < 4; ++m) {
                const int R = R0 + ai * HALF + m * 16;
                const int b = R / NCH, ch = R - b * NCH;
                if (R < SROWS && ch >= 16) {
#pragma unroll
                    for (int bj = 0; bj < 2; ++bj) {
                        const int n = n0 + bj * HALF, t = n >> 4, co = n & 15;
                        const f32x4 v0 = acc[ai][bj][m][0], v1 = acc[ai][bj][m][1];
                        u32x4 w; w.x = cvt_pk_bf16(gelu_tanh_f(v0[0]), gelu_tanh_f(v0[1])); w.y = cvt_pk_bf16(gelu_tanh_f(v0[2]), gelu_tanh_f(v0[3]));
                        w.z = cvt_pk_bf16(gelu_tanh_f(v1[0]), gelu_tanh_f(v1[1])); w.w = cvt_pk_bf16(gelu_tanh_f(v1[2]), gelu_tanh_f(v1[3]));
                        *(u32x4*)(YG + ((size_t)(b * SEQ + (ch - 16) * 16 + t) * SSMW + grp * 16 + co)) = w;
                    }
                }
            }
    }
};
struct EpiGlu {
    static constexpr bool PERM = true; static constexpr int MID_T = -1;
    const bf16_t* YG; const float* bias; bf16_t* Y2;
    __device__ __forceinline__ void operator()(const AccT& acc, const Unit& u, int wr, int wc, int fr, int fq) const {
        const int row0 = u.pm * BM + wr * 64 + fr, col0 = u.pn * BM + wc * 32 + 8 * fq;
        f32x4 bv[2][2];
#pragma unroll
        for (int bj = 0; bj < 2; ++bj)
#pragma unroll
            for (int n = 0; n < 2; ++n) bv[bj][n] = *(const f32x4*)(bias + col0 + bj * HALF + 4 * n);
#pragma unroll
        for (int ai = 0; ai < 2; ++ai) {
            u32x4 yv[4][2];
#pragma unroll
            for (int m = 0; m < 4; ++m)
#pragma unroll
                for (int bj = 0; bj < 2; ++bj) yv[m][bj] = *(const u32x4*)(YG + (size_t)(row0 + ai * HALF + m * 16) * SSMW + col0 + bj * HALF);
#pragma unroll
            for (int m = 0; m < 4; ++m) {
                const size_t off = (size_t)(row0 + ai * HALF + m * 16) * SSMW + col0;
#pragma unroll
                for (int bj = 0; bj < 2; ++bj) {
                    const u32x4 y = yv[m][bj];
                    const f32x4 v0 = acc[ai][bj][m][0] + bv[bj][0], v1 = acc[ai][bj][m][1] + bv[bj][1];
                    u32x4 w;
                    w.x = cvt_pk_bf16(bf_lo(y.x) * sigmoid_f(v0[0]), bf_hi(y.x) * sigmoid_f(v0[1])); w.y = cvt_pk_bf16(bf_lo(y.y) * sigmoid_f(v0[2]), bf_hi(y.y) * sigmoid_f(v0[3]));
                    w.z = cvt_pk_bf16(bf_lo(y.z) * sigmoid_f(v1[0]), bf_hi(y.z) * sigmoid_f(v1[1])); w.w = cvt_pk_bf16(bf_lo(y.w) * sigmoid_f(v1[2]), bf_hi(y.w) * sigmoid_f(v1[3]));
                    *(u32x4*)(Y2 + (size_t)(row0 + ai * HALF + m * 16) * LDAY + 2048 + col0 + bj * HALF) = w;
                }
            }
        }
    }
};
template <int STEP> struct EpiMerge {
    static constexpr bool PERM = true; static constexpr int MID_T = -1;
    const bf16_t* GATE; float* TMP; bf16_t* MERGED;
    __device__ __forceinline__ void operator()(const AccT& acc, const Unit& u, int wr, int wc, int fr, int fq) const {
        const int row0 = u.pm * BM + wr * 64 + fr, col0 = u.pn * BM + wc * 32 + 8 * fq;
#pragma unroll
        for (int ai = 0; ai < 2; ++ai)
#pragma unroll
            for (int mh = 0; mh < 2; ++mh) {
                u32x4 gt[2][2]; f32x4 t0[2][2], t1[2][2];
#pragma unroll
                for (int mm = 0; mm < 2; ++mm)
#pragma unroll
                    for (int bj = 0; bj < 2; ++bj) {
                        const int row = row0 + ai * HALF + (mh * 2 + mm) * 16, col = col0 + bj * HALF;
                        gt[mm][bj] = *(const u32x4*)(GATE + (size_t)row * 4096 + (STEP == 1 ? 0 : 2048) + col);
                        if (STEP == 2) { const float* tp = TMP + (size_t)row * DM + col; t0[mm][bj] = *(const f32x4*)tp; t1[mm][bj] = *(const f32x4*)(tp + 4); }
                    }
#pragma unroll
                for (int mm = 0; mm < 2; ++mm)
#pragma unroll
                    for (int bj = 0; bj < 2; ++bj) {
                        const int m = mh * 2 + mm, row = row0 + ai * HALF + m * 16, col = col0 + bj * HALF;
                        const u32x4 g = gt[mm][bj];
                        const f32x4 g0 = (f32x4){bf_lo(g.x), bf_hi(g.x), bf_lo(g.y), bf_hi(g.y)}, g1 = (f32x4){bf_lo(g.z), bf_hi(g.z), bf_lo(g.w), bf_hi(g.w)};
                        if (STEP == 1) { float* tp = TMP + (size_t)row * DM + col; *(f32x4*)tp = g0 * acc[ai][bj][m][0]; *(f32x4*)(tp + 4) = g1 * acc[ai][bj][m][1]; }
                        else { const f32x4 v0 = t0[mm][bj] + g0 * acc[ai][bj][m][0], v1 = t1[mm][bj] + g1 * acc[ai][bj][m][1];
                            u32x4 w; w.x = cvt_pk_bf16(v0[0], v0[1]); w.y = cvt_pk_bf16(v0[2], v0[3]); w.z = cvt_pk_bf16(v1[0], v1[1]); w.w = cvt_pk_bf16(v1[2], v1[3]);
                            *(u32x4*)(MERGED + (size_t)row * DM + col) = w; }
                    }
            }
    }
};
struct EpiMergeF {
    static constexpr bool PERM = true; static constexpr int MID_T = 32;
    const bf16_t* GATE; bf16_t* MERGED;
    __device__ __forceinline__ void mid(AccT& acc, const Unit& u, int wr, int wc, int fr, int fq) const {
        const bf16_t* gbase = GATE + (size_t)(u.pm * BM + wr * 64 + fr) * 4096 + u.pn * BM + wc * 32 + 8 * fq;
#define MF_LOAD(i, A, B) do { const bf16_t* gp = gbase + (size_t)((((i) >> 3) * HALF) + (((i) >> 1) & 3) * 16) * 4096 + ((i) & 1) * HALF; A = *(const u32x4*)gp; B = *(const u32x4*)(gp + 2048); } while (0)
#define MF_R(x, y) ((x) * __builtin_amdgcn_rcpf(fmaxf((y), 1e-30f)))
#define MF_APPLY(i, A, B) do { f32x4& c0 = acc[(i) >> 3][(i) & 1][((i) >> 1) & 3][0]; f32x4& c1 = acc[(i) >> 3][(i) & 1][((i) >> 1) & 3][1]; \
        c0[0] *= MF_R(bf_lo(A.x), bf_lo(B.x)); c0[1] *= MF_R(bf_hi(A.x), bf_hi(B.x)); c0[2] *= MF_R(bf_lo(A.y), bf_lo(B.y)); c0[3] *= MF_R(bf_hi(A.y), bf_hi(B.y)); \
        c1[0] *= MF_R(bf_lo(A.z), bf_lo(B.z)); c1[1] *= MF_R(bf_hi(A.z), bf_hi(B.z)); c1[2] *= MF_R(bf_lo(A.w), bf_lo(B.w)); c1[3] *= MF_R(bf_hi(A.w), bf_hi(B.w)); } while (0)
        u32x4 a0, b0, a1, b1;
        MF_LOAD(0, a0, b0);
#pragma unroll
        for (int i = 0; i < 16; i += 2) {
            MF_LOAD(i + 1, a1, b1); __builtin_amdgcn_sched_barrier(0);
            MF_APPLY(i, a0, b0); __builtin_amdgcn_sched_barrier(0);
            if (i + 2 < 16) MF_LOAD(i + 2, a0, b0);
            __builtin_amdgcn_sched_barrier(0);
            MF_APPLY(i + 1, a1, b1); __builtin_amdgcn_sched_barrier(0);
        }
#undef MF_LOAD
#undef MF_R
#undef MF_APPLY
    }
    __device__ __forceinline__ void operator()(const AccT& acc, const Unit& u, int wr, int wc, int fr, int fq) const {
        const int row0 = u.pm * BM + wr * 64 + fr, col0 = u.pn * BM + wc * 32 + 8 * fq;
#pragma unroll
        for (int ai = 0; ai < 2; ++ai) {
            u32x4 gs[4][2];
#pragma unroll
            for (int m = 0; m < 4; ++m)
#pragma unroll
                for (int bj = 0; bj < 2; ++bj) gs[m][bj] = *(const u32x4*)(GATE + (size_t)(row0 + ai * HALF + m * 16) * 4096 + 2048 + col0 + bj * HALF);
#pragma unroll
            for (int m = 0; m < 4; ++m)
#pragma unroll
                for (int bj = 0; bj < 2; ++bj) {
                    const u32x4 b = gs[m][bj];
                    const f32x4 v0 = acc[ai][bj][m][0] * (f32x4){bf_lo(b.x), bf_hi(b.x), bf_lo(b.y), bf_hi(b.y)}, v1 = acc[ai][bj][m][1] * (f32x4){bf_lo(b.z), bf_hi(b.z), bf_lo(b.w), bf_hi(b.w)};
                    u32x4 w; w.x = cvt_pk_bf16(v0[0], v0[1]); w.y = cvt_pk_bf16(v0[2], v0[3]); w.z = cvt_pk_bf16(v1[0], v1[1]); w.w = cvt_pk_bf16(v1[2], v1[3]);
                    *(u32x4*)(MERGED + (size_t)(row0 + ai * HALF + m * 16) * DM + col0 + bj * HALF) = w;
                }
        }
    }
};
}

namespace att {
constexpr int D = 128, NW = 8, QBLK = 32, KVBLK = 64;
constexpr float SCALE = 0.088388347648318440f, THR = 8.f;
constexpr int LDQ = DM, LDK = 512, LDO = LDAY;
constexpr size_t SHM_V = KVBLK * D * 2, SHM_K = KVBLK * D * 2, SHM_ATTN = 2 * SHM_V + 2 * SHM_K + NW * 64 * 4;
#define KSWZ(row, colB) ((row) * 256 + ((colB) ^ (((row) & 7) << 4)))
#define SBAR() __builtin_amdgcn_sched_barrier(0)
__device__ __forceinline__ int crow(int r, int hi) { return (r & 3) + 8 * (r >> 2) + 4 * hi; }
__device__ __forceinline__ void partialSM(f32x16& p0, f32x16& p1, float& m_reg, float& mn, float& alpha) {
  constexpr float C = SCALE * 1.4426950408889634f;
  float pmax = p0[0]; for (int r = 1; r < 16; ++r) pmax = fmaxf(pmax, p0[r]); for (int r = 0; r < 16; ++r) pmax = fmaxf(pmax, p1[r]);
  { auto rr = __builtin_amdgcn_permlane32_swap(__float_as_uint(pmax), __float_as_uint(pmax), false, false);
    pmax = fmaxf(__uint_as_float(rr[0]), __uint_as_float(rr[1])); }
  if (__builtin_expect(__all(pmax - m_reg <= THR / SCALE), 1)) { mn = m_reg; alpha = 1.f; }
  else { mn = fmaxf(m_reg, pmax); alpha = __builtin_amdgcn_exp2f((m_reg - mn) * C); m_reg = mn; }
  float mnC = -mn * C;
  for (int r = 0; r < 16; ++r) p0[r] = fmaf(p0[r], C, mnC); for (int r = 0; r < 16; ++r) p1[r] = fmaf(p1[r], C, mnC);
  for (int r = 0; r < 16; ++r) p0[r] = __builtin_amdgcn_exp2f(p0[r]);
}
__device__ __forceinline__ void finishSM(f32x16& p0, f32x16& p1, float alpha, float& l_reg, bf16x8& pa0, bf16x8& pa1, bf16x8& pa2, bf16x8& pa3) {
  for (int r = 0; r < 16; ++r) p1[r] = __builtin_amdgcn_exp2f(p1[r]);
  float ps = 0; for (int r = 0; r < 16; ++r) ps += p0[r]; for (int r = 0; r < 16; ++r) ps += p1[r];
  { auto rr = __builtin_amdgcn_permlane32_swap(__float_as_uint(ps), __float_as_uint(ps), false, false);
    ps = __uint_as_float(rr[0]) + __uint_as_float(rr[1]); }
  l_reg = l_reg * alpha + ps;
#define PK4(P, BASE, OUT) do { unsigned a0 = cvt_pk_bf16(P[BASE + 0], P[BASE + 1]), a1 = cvt_pk_bf16(P[BASE + 2], P[BASE + 3]);   \
    unsigned b0 = cvt_pk_bf16(P[BASE + 4], P[BASE + 5]), b1 = cvt_pk_bf16(P[BASE + 6], P[BASE + 7]);                              \
    auto r0 = __builtin_amdgcn_permlane32_swap(a0, b0, false, false); auto r1 = __builtin_amdgcn_permlane32_swap(a1, b1, false, false); \
    u32x4 w = {r0[0], r1[0], r0[1], r1[1]}; OUT = *reinterpret_cast<bf16x8*>(&w); } while (0)
  PK4(p0, 0, pa0); PK4(p0, 8, pa1); PK4(p1, 0, pa2); PK4(p1, 8, pa3);
#undef PK4
}
__device__ __forceinline__ void qkt(f32x16& p0, f32x16& p1, const bf16_t* Ks, const bf16x8* qr, int r32, int hi) {
  p0 = f32x16{}; p1 = f32x16{};
  for (int d0 = 0; d0 < 8; ++d0) { int cb = (d0 * 16 + hi * 8) * 2;
    bf16x8 b0 = *reinterpret_cast<const bf16x8*>((const char*)Ks + KSWZ(r32, cb));
    bf16x8 b1 = *reinterpret_cast<const bf16x8*>((const char*)Ks + KSWZ(32 + r32, cb));
    p0 = __builtin_amdgcn_mfma_f32_32x32x16_bf16(b0, qr[d0], p0, 0, 0, 0);
    p1 = __builtin_amdgcn_mfma_f32_32x32x16_bf16(b1, qr[d0], p1, 0, 0, 0); }
}
__device__ __forceinline__ int v_st(int k, int c) { const int kk = (k & ~0xC) | ((k & 4) << 1) | ((k & 8) >> 1); return ((kk >> 3) * 4 + (c >> 5)) * 512 + ((kk & 7) * 32 + (c & 31)) * 2; }
__device__ __forceinline__ int v_rd_base(int lane) { return ((lane & 3) << 3) | (((lane >> 2) & 3) << 6) | (((lane >> 4) & 1) << 5) | (((lane >> 5) & 1) << 8); }
constexpr int v_rd_off(int d0, int ks, int half) { return d0 * 512 + ks * 4096 + half * 2048; }
template <int OFF> __device__ __forceinline__ s16x4 tr_read(int vb) {
  s16x4 r; asm volatile("ds_read_b64_tr_b16 %0, %1 offset:%2" : "=&v"(r) : "v"(vb), "i"(OFF) : "memory"); return r;
}
template <int D0> __device__ __forceinline__ void pv_one(f32x16& od, int vb, bf16x8 pa0, bf16x8 pa1, bf16x8 pa2, bf16x8 pa3) {
  const s16x4 l0 = tr_read<v_rd_off(D0, 0, 0)>(vb), h0 = tr_read<v_rd_off(D0, 0, 1)>(vb), l1 = tr_read<v_rd_off(D0, 1, 0)>(vb), h1 = tr_read<v_rd_off(D0, 1, 1)>(vb);
  const s16x4 l2 = tr_read<v_rd_off(D0, 2, 0)>(vb), h2 = tr_read<v_rd_off(D0, 2, 1)>(vb), l3 = tr_read<v_rd_off(D0, 3, 0)>(vb), h3 = tr_read<v_rd_off(D0, 3, 1)>(vb);
  asm volatile("s_waitcnt lgkmcnt(0)" ::: "memory"); SBAR();
#define PK(L, H) (bf16x8){L[0], L[1], L[2], L[3], H[0], H[1], H[2], H[3]}
  od = __builtin_amdgcn_mfma_f32_32x32x16_bf16(pa0, PK(l0, h0), od, 0, 0, 0);
  od = __builtin_amdgcn_mfma_f32_32x32x16_bf16(pa1, PK(l1, h1), od, 0, 0, 0);
  od = __builtin_amdgcn_mfma_f32_32x32x16_bf16(pa2, PK(l2, h2), od, 0, 0, 0);
  od = __builtin_amdgcn_mfma_f32_32x32x16_bf16(pa3, PK(l3, h3), od, 0, 0, 0);
#undef PK
}
__device__ __forceinline__ void pv_d0(f32x16* o, int vb, bf16x8 pa0, bf16x8 pa1, bf16x8 pa2, bf16x8 pa3) {
  pv_one<0>(o[0], vb, pa0, pa1, pa2, pa3); pv_one<1>(o[1], vb, pa0, pa1, pa2, pa3); pv_one<2>(o[2], vb, pa0, pa1, pa2, pa3); pv_one<3>(o[3], vb, pa0, pa1, pa2, pa3);
}
__device__ __forceinline__ void attn_dense_body(const bf16_t* Qb, const bf16_t* __restrict__ Kh, const bf16_t* __restrict__ Vh, bf16_t* Ob, int seq, char* lds) {
  const int tid = threadIdx.x, wid = tid >> 6, lane = tid & 63, r32 = lane & 31, hi = lane >> 5;
  bf16_t* V_lds = (bf16_t*)lds; bf16_t* K_lds = (bf16_t*)(lds + 2 * SHM_V);
  float* ws = (float*)(lds + 2 * SHM_V + 2 * SHM_K) + wid * 64; float* li_l = ws; float* al_l = ws + 32;
  float m_reg = -1e30f, l_reg = 0; f32x16 o[4] = {}; bf16x8 qr[8];
  const bf16_t* Qw = Qb + (long)(wid * QBLK + r32) * LDQ + hi * 8;
#pragma unroll
  for (int d0 = 0; d0 < 8; ++d0) qr[d0] = *reinterpret_cast<const bf16x8*>(Qw + d0 * 16);
  const int sr = tid >> 4, sc = (tid & 15) * 8, vst0 = v_st(sr, sc), vst1 = v_st(32 + sr, sc);
  const int vb0 = (int)(uintptr_t)V_lds + v_rd_base(lane);
  struct { bf16x8 vs0, vs1, ks0, ks1; } sr_[2];
#define SLOAD(i, k0) do { sr_[i].vs0 = *reinterpret_cast<const bf16x8*>(&Vh[(long)((k0) + sr) * LDK + sc]); sr_[i].vs1 = *reinterpret_cast<const bf16x8*>(&Vh[(long)((k0) + 32 + sr) * LDK + sc]); \
    sr_[i].ks0 = *reinterpret_cast<const bf16x8*>(&Kh[(long)((k0) + sr) * LDK + sc]); sr_[i].ks1 = *reinterpret_cast<const bf16x8*>(&Kh[(long)((k0) + 32 + sr) * LDK + sc]); } while (0)
#define SWRITE(b, i) do { *(bf16x8*)((char*)V_lds + (b) * SHM_V + vst0) = sr_[i].vs0;          \
    *(bf16x8*)((char*)V_lds + (b) * SHM_V + vst1) = sr_[i].vs1; int kc = sc * 2;               \
    *(bf16x8*)((char*)K_lds + (b) * SHM_K + KSWZ(sr, kc)) = sr_[i].ks0;                       \
    *(bf16x8*)((char*)K_lds + (b) * SHM_K + KSWZ(32 + sr, kc)) = sr_[i].ks1; } while (0)
#define SWAIT() asm volatile("s_waitcnt vmcnt(4)" ::: "memory")
#define RESC(a) do { if (__any((a) < 1.f)) { if (hi == 0) al_l[r32] = (a); asm volatile("s_waitcnt lgkmcnt(0)" ::: "memory"); \
    for (int d = 0; d < 4; ++d) for (int r = 0; r < 16; ++r) o[d][r] *= al_l[crow(r, hi)]; } } while (0)
  f32x16 pA0, pA1, pB0, pB1; float mnA, mnB, alA, alB; bf16x8 pa0, pa1, pa2, pa3; const int NT = seq / KVBLK;
  constexpr int SE = 0, SO = 1;
  SLOAD(SE, 0); asm volatile("s_waitcnt vmcnt(0)" ::: "memory"); SWRITE(0, SE); __syncthreads();
  qkt(pA0, pA1, K_lds, qr, r32, hi); partialSM(pA0, pA1, m_reg, mnA, alA);
  SLOAD(SO, KVBLK); if (2 < NT) SLOAD(SE, 2 * KVBLK);
  SWAIT(); SWRITE(1, SO); __syncthreads();
  for (int j = 1; j + 1 < NT; j += 2) {
    SBAR(); qkt(pB0, pB1, (bf16_t*)((char*)K_lds + SHM_K), qr, r32, hi);
    finishSM(pA0, pA1, alA, l_reg, pa0, pa1, pa2, pa3); SBAR();
    SLOAD(SO, (j + 2) * KVBLK); SBAR();
    pv_d0(o, vb0, pa0, pa1, pa2, pa3); partialSM(pB0, pB1, m_reg, mnB, alB);
    __syncthreads(); SWAIT(); SWRITE(0, SE);
    RESC(alB); __syncthreads();
    SBAR(); qkt(pA0, pA1, K_lds, qr, r32, hi);
    finishSM(pB0, pB1, alB, l_reg, pa0, pa1, pa2, pa3); SBAR();
    if (j + 3 < NT) SLOAD(SE, (j + 3) * KVBLK); SBAR();
    pv_d0(o, vb0 + (int)SHM_V, pa0, pa1, pa2, pa3); partialSM(pA0, pA1, m_reg, mnA, alA);
    __syncthreads(); SWAIT(); SWRITE(1, SO);
    RESC(alA); __syncthreads();
  }
  SBAR(); qkt(pB0, pB1, (bf16_t*)((char*)K_lds + SHM_K), qr, r32, hi);
  finishSM(pA0, pA1, alA, l_reg, pa0, pa1, pa2, pa3); SBAR();
  pv_d0(o, vb0, pa0, pa1, pa2, pa3); partialSM(pB0, pB1, m_reg, mnB, alB);
  __syncthreads(); RESC(alB);
  finishSM(pB0, pB1, alB, l_reg, pa0, pa1, pa2, pa3); SBAR();
  pv_d0(o, vb0 + (int)SHM_V, pa0, pa1, pa2, pa3);
  if (hi == 0) li_l[r32] = l_reg; asm volatile("s_waitcnt lgkmcnt(0)" ::: "memory");
  float rli[16];
#pragma unroll
  for (int r = 0; r < 16; ++r) rli[r] = __builtin_amdgcn_rcpf(li_l[crow(r, hi)]);
  bf16_t* Ow = Ob + (long)(wid * QBLK) * LDO;
#pragma unroll
  for (int r = 0; r < 16; ++r) { int orow = crow(r, hi);
    for (int d0 = 0; d0 < 4; ++d0) Ow[(long)orow * LDO + d0 * 32 + r32] = (bf16_t)(cvt_pk_bf16(o[d0][r] * rli[r], 0.f) & 0xffffu); }
  __syncthreads();
#undef SLOAD
#undef SWRITE
#undef SWAIT
#undef RESC
}
}

struct Args { const float* in[29]; float* out; unsigned char* ws; int ph_lo, ph_hi; };

__device__ __forceinline__ void mod_phase(const Args& a, float* MOD, LAS unsigned char* lds, int tid) {
    LAS float* sc = (LAS float*)lds;
    LAS float* red = sc + 5 * DM;
    const float* c = a.in[1]; const float* cc = a.in[3]; const float* wm = a.in[4]; const float* bm = a.in[5];
    for (int i = tid; i < 5 * DM; i += 512) { const float v = i < 4 * DM ? c[i] : cc[i - 4 * DM]; sc[i] = silu_f(v); }
    __syncthreads();
    for (int cb = blockIdx.x; cb < NMOD / 72; cb += gridDim.x) {
        const int cg_ = tid % 18, kg = tid / 18;
        if (kg < 28) {
            f32x4 acc[5];
#pragma unroll
            for (int r = 0; r < 5; ++r) acc[r] = (f32x4){0.f, 0.f, 0.f, 0.f};
            const float* wp = wm + (size_t)cb * 72 + cg_ * 4;
#pragma unroll 8
            for (int k = kg; k < DM; k += 28) {
                const f32x4 w = __builtin_nontemporal_load((const f32x4*)(wp + (size_t)k * NMOD));
#pragma unroll
                for (int r = 0; r < 5; ++r) acc[r] += w * sc[r * DM + k];
            }
#pragma unroll
            for (int r = 0; r < 5; ++r)
#pragma unroll
                for (int j = 0; j < 4; ++j) red[(kg * 5 + r) * 72 + cg_ * 4 + j] = acc[r][j];
        }
        __syncthreads();
        if (tid < 360) { const int r = tid / 72, col = tid % 72; float s = bm[cb * 72 + col];
            for (int kg2 = 0; kg2 < 28; ++kg2) s += red[(kg2 * 5 + r) * 72 + col];
            MOD[(size_t)r * NMOD + cb * 72 + col] = s; }
        __syncthreads();
    }
}

struct CvtItem { const float* wp; bf16_t* dp; int N, K; };
__device__ __forceinline__ CvtItem cvt_decode(const Args& a, unsigned char* ws, int it, int lane) {
    constexpr int I_GU = (DM / 64) * (DFF / 32), I_DN = (DFF / 64) * (DM / 32), I_IN = (DM / 64) * (INW / 32), I_GLU = (SSMW / 64) * (SSMW / 32),
                  I_BRA = (DM / 64) * (DM / 32), I_BRS = (SSMW / 64) * (DM / 32), I_OUT = I_BRA;
    int r = it; const float* W; int K, N, mode = 0, ldw = 0; bf16_t* WT;
    if (r < I_GU) { W = a.in[7]; K = DM; N = DFF; WT = (bf16_t*)(ws + WS_W1GU); mode = 1; }
    else if ((r -= I_GU) < I_GU) { W = a.in[8]; K = DM; N = DFF; WT = (bf16_t*)(ws + WS_W1GU); mode = 2; }
    else if ((r -= I_GU) < I_DN) { W = a.in[9]; K = DFF; N = DM; WT = (bf16_t*)(ws + WS_W1D); }
    else if ((r -= I_DN) < I_IN) { W = a.in[10]; K = DM; N = INW; WT = (bf16_t*)(ws + WS_WIN); }
    else if ((r -= I_IN) < I_GLU) { W = a.in[21]; K = SSMW; N = SSMW; WT = (bf16_t*)(ws + WS_WGLU); }
    else if ((r -= I_GLU) < I_BRA) { W = a.in[23]; K = DM; N = DM; WT = (bf16_t*)(ws + WS_WBRA); ldw = LDAY; }
    else if ((r -= I_BRA) < I_BRS) { W = a.in[24]; K = SSMW; N = DM; WT = (bf16_t*)(ws + WS_WBRA) + 2048; ldw = LDAY; }
    else if ((r -= I_BRS) < I_OUT) { W = a.in[25]; K = DM; N = DM; WT = (bf16_t*)(ws + WS_WOUT); }
    else if ((r -= I_OUT) < I_GU) { W = a.in[26]; K = DM; N = DFF; WT = (bf16_t*)(ws + WS_W2GU); mode = 1; }
    else if ((r -= I_GU) < I_GU) { W = a.in[27]; K = DM; N = DFF; WT = (bf16_t*)(ws + WS_W2GU); mode = 2; }
    else { r -= I_GU; W = a.in[28]; K = DFF; N = DM; WT = (bf16_t*)(ws + WS_W2D); }
    const int nblk = N / 32, kb = r / nblk, nb = r % nblk, n0 = nb * 32, k0 = kb * 64;
    const int drow0 = mode == 0 ? n0 : ((n0 >> 7) * 256 + (mode == 2 ? 128 : 0) + (n0 & 127));
    CvtItem c; c.wp = W + (size_t)(k0 + (lane >> 5)) * N + n0 + (lane & 31); if (ldw == 0) ldw = K; c.dp = WT + (size_t)drow0 * ldw + k0; c.N = N; c.K = ldw; return c;
}
__device__ __forceinline__ void cvt_load(float (&v)[32], const CvtItem& c) {
#pragma unroll
    for (int i = 0; i < 32; ++i) v[i] = __builtin_nontemporal_load(c.wp + (size_t)(2 * i) * c.N);
}
__device__ __forceinline__ void cvt_store(const float (&v)[32], const CvtItem& c, LAS float* scr, int lane) {
#pragma unroll
    for (int i = 0; i < 32; ++i) scr[(2 * i + (lane >> 5)) * 33 + (lane & 31)] = v[i];
    LDS_WAIT();
    const int cc = lane & 7;
#pragma unroll
    for (int j = 0; j < 4; ++j) { const int n = (lane >> 3) + 8 * j; const LAS float* s = scr + (8 * cc) * 33 + n;
        u32x4 o; o.x = cvt_pk_bf16(s[0 * 33], s[1 * 33]); o.y = cvt_pk_bf16(s[2 * 33], s[3 * 33]); o.z = cvt_pk_bf16(s[4 * 33], s[5 * 33]); o.w = cvt_pk_bf16(s[6 * 33], s[7 * 33]);
        *(u32x4*)(c.dp + (size_t)n * c.K + 8 * cc) = o; }
    LDS_WAIT();
}
__device__ __forceinline__ void weights_phase(const Args& a, unsigned char* ws, LAS unsigned char* lds, int wave, int lane) {
    LAS float* scr = (LAS float*)(lds + wave * 8704);
    const int gw = blockIdx.x * 8 + wave, NGW = gridDim.x * 8;
    constexpr int NITEMS = 47616;
    float va[32], vb[32]; CvtItem ca, cb;
    int it = gw;
    if (it < NITEMS) { ca = cvt_decode(a, ws, it, lane); cvt_load(va, ca); }
    while (it < NITEMS) {
        const int it2 = it + NGW, it3 = it2 + NGW;
        if (it2 < NITEMS) { cb = cvt_decode(a, ws, it2, lane); cvt_load(vb, cb); }
        cvt_store(va, ca, scr, lane);
        if (it3 < NITEMS) { ca = cvt_decode(a, ws, it3, lane); cvt_load(va, ca); }
        if (it2 < NITEMS) cvt_store(vb, cb, scr, lane);
        it = it3;
    }
    __syncthreads();
}

__device__ __forceinline__ void ssm_params_phase(const Args& a, unsigned char* ws, LAS unsigned char* lds, int tid, int wi0, int wi_end, int wi_step) {
    LAS f32x2* lbp = (LAS f32x2*)lds;
    LAS f32x2* Bb = lbp + 2 * 17 * 64;
    LAS f32x2* Cc = Bb + 2 * 64 * 16;
    LAS float* KF = (LAS float*)(Cc + 2 * 16 * 64);
    LAS f32x2* cf = (LAS f32x2*)(KF + 2 * 16 * 256);
    const float *a_re = a.in[13], *a_im = a.in[14], *log_dt = a.in[15], *b_re = a.in[16], *b_im = a.in[17], *c_re = a.in[18], *c_im = a.in[19], *dvec = a.in[20];
    bf16_t* WY = (bf16_t*)(ws + WS_WY); bf16_t* WST = (bf16_t*)(ws + WS_WST);
    for (int wi = wi0; wi < wi_end; wi += wi_step) {
        const int g = wi >> 2, q = wi & 3;
        if (tid < 128) {
            const int dir = tid >> 6, p = tid & 63;
            const float dt = expf(log_dt[dir * 64 + g]), ar = a_re[(dir * 64 + g) * 64 + p], ai = a_im[(dir * 64 + g) * 64 + p];
            const float x = ar * dt, y = ai * dt, mag = expf(x), cy = cosf(y), sy = sinf(y), sh = sinf(0.5f * y);
            const f32x2 lb = (f32x2){mag * cy, mag * sy};
            const float lm1r = expm1f(x) * cy - 2.f * sh * sh, lm1i = lb.y, den = ar * ar + ai * ai;
            cf[tid] = (f32x2){(lm1r * ar + lm1i * ai) / den, (lm1i * ar - lm1r * ai) / den};
            f32x2 w = (f32x2){1.f, 0.f};
            for (int e = 0; e <= 16; ++e) { lbp[(dir * 17 + e) * 64 + p] = w; w = cmul(w, lb); }
        }
        __syncthreads();
#pragma unroll
        for (int i = 0; i < 4; ++i) {
            const int idx = tid + 512 * i, dir = idx >> 10;
            { const int p = (idx >> 4) & 63, c = idx & 15, src = ((dir * 64 + g) * 64 + p) * 16 + c; Bb[idx] = cmul(cf[dir * 64 + p], (f32x2){b_re[src], b_im[src]}); }
            { const int co = (idx >> 6) & 15, p = idx & 63, src = ((dir * 64 + g) * 16 + co) * 64 + p; Cc[idx] = (f32x2){c_re[src], c_im[src]}; }
        }
        __syncthreads();
        {
            const int dir = tid >> 8, co = (tid >> 4) & 15, ci = tid & 15;
            float acc[16];
#pragma unroll
            for (int j = 0; j < 16; ++j) acc[j] = 0.f;
            for (int p = 0; p < 64; ++p) {
                f32x2 w = cmul(Cc[(dir * 16 + co) * 64 + p], Bb[(dir * 64 + p) * 16 + ci]); const f32x2 lb = lbp[(dir * 17 + 1) * 64 + p];
#pragma unroll
                for (int j = 0; j < 16; ++j) { acc[j] += w.x; w = cmul(w, lb); }
            }
#pragma unroll
            for (int j = 0; j < 16; ++j) KF[(dir * 16 + j) * 256 + co * 16 + ci] = acc[j];
        }
        __syncthreads();
#pragma unroll 1
        for (int i = 0; i < 8; ++i) {
            const int v = tid + 512 * i, n = 64 * q + (v >> 6), k0 = (v & 63) * 8, t = n >> 4, co = n & 15;
            float vals[8];
            if (k0 < 256) { const int s = k0 >> 4, ci0 = k0 & 15;
#pragma unroll
                for (int e = 0; e < 8; ++e) { const int idx = co * 16 + ci0 + e; float val;
                    if (s < t) val = KF[(t - s) * 256 + idx]; else if (s > t) val = KF[(16 + s - t) * 256 + idx];
                    else val = KF[idx] + KF[16 * 256 + idx] + ((co == ci0 + e) ? dvec[g * 16 + co] : 0.f);
                    vals[e] = val; }
            } else { const int kk = k0 - 256, dir = kk >> 7, p0 = (kk & 127) >> 1, ex = dir == 0 ? t + 1 : 16 - t;
#pragma unroll
                for (int pp = 0; pp < 4; ++pp) { const f32x2 cl = cmul(Cc[(dir * 16 + co) * 64 + p0 + pp], lbp[(dir * 17 + ex) * 64 + p0 + pp]); vals[2 * pp] = cl.x; vals[2 * pp + 1] = -cl.y; }
            }
            u32x4 w; w.x = cvt_pk_bf16(vals[0], vals[1]); w.y = cvt_pk_bf16(vals[2], vals[3]); w.z = cvt_pk_bf16(vals[4], vals[5]); w.w = cvt_pk_bf16(vals[6], vals[7]);
            *(u32x4*)(WY + ((size_t)(g * 256 + n) * 512 + k0)) = w;
        }
#pragma unroll 1
        for (int i = 0; i < 4; ++i) {
            const int v = tid + 512 * i, n = 64 * q + (v >> 5), k0 = (v & 31) * 8, dir = n >> 7, p = (n & 127) >> 1, ri = n & 1, t = k0 >> 4, c0 = k0 & 15;
            const f32x2 l = lbp[(dir * 17 + (dir == 0 ? 15 - t : t)) * 64 + p];
            float vals[8];
#pragma unroll
            for (int e = 0; e < 8; ++e) { const f32x2 z = cmul(l, Bb[(dir * 64 + p) * 16 + c0 + e]); vals[e] = ri ? z.y : z.x; }
            u32x4 w; w.x = cvt_pk_bf16(vals[0], vals[1]); w.y = cvt_pk_bf16(vals[2], vals[3]); w.z = cvt_pk_bf16(vals[4], vals[5]); w.w = cvt_pk_bf16(vals[6], vals[7]);
            *(u32x4*)(WST + ((size_t)(g * 256 + n) * 256 + k0)) = w;
        }
        __syncthreads();
    }
}

template <bool SLABS, bool DELTA>
__device__ __forceinline__ void norm_phase(const float* xlat, const float* xctx, const float* gam, const float* MOD, int sh_off, int sc_off, bf16_t* H, int nrows, int wave, int lane, const float* slabs = nullptr, const bf16_t* delta = nullptr) {
    const int gw = blockIdx.x * 8 + wave, NGW = gridDim.x * 8;
    for (int m = gw; m < nrows; m += NGW) {
        const float* xr = (m < ML ? xlat + (size_t)m * DM : xctx + (size_t)(m - ML) * DM) + lane * 4;
        const float* mr = MOD + (size_t)(m < ML ? (m >> 11) : 4) * NMOD + lane * 4;
        f32x4 v[8]; float ss = 0.f;
#pragma unroll
        for (int j = 0; j < 8; ++j) { v[j] = *(const f32x4*)(xr + 256 * j);
            if (DELTA && m < ML) { const u32x2 dd = *(const u32x2*)(delta + (size_t)m * DM + lane * 4 + 256 * j); v[j] += (f32x4){bf_lo(dd.x), bf_hi(dd.x), bf_lo(dd.y), bf_hi(dd.y)}; }
            if (SLABS && m >= ML) { const float* sp = slabs + (size_t)(m - ML) * DM + lane * 4 + 256 * j;
                const f32x4 p = (*(const f32x4*)sp + *(const f32x4*)(sp + (size_t)MC * DM)) + (*(const f32x4*)(sp + (size_t)2 * MC * DM) + *(const f32x4*)(sp + (size_t)3 * MC * DM));
                v[j] += (*(const f32x4*)(mr + 2 * DM + 256 * j) * 0.5f) * p; }
            ss += (v[j].x * v[j].x + v[j].y * v[j].y) + (v[j].z * v[j].z + v[j].w * v[j].w); }
        const float rstd = rsqrtf(wave_sum(ss) * (1.f / DM) + EPS);
#pragma unroll
        for (int j = 0; j < 8; ++j) {
            const f32x4 gg = *(const f32x4*)(gam + lane * 4 + 256 * j), sh = *(const f32x4*)(mr + sh_off + 256 * j), sc = *(const f32x4*)(mr + sc_off + 256 * j);
            const f32x4 h = (v[j] * rstd) * gg * (sc + 1.f) + sh;
            u32x2 w; w.x = cvt_pk_bf16(h.x, h.y); w.y = cvt_pk_bf16(h.z, h.w);
            *(u32x2*)(H + (size_t)m * DM + lane * 4 + 256 * j) = w;
        }
    }
}

__device__ __forceinline__ void qknorm_phase(bf16_t* Q, bf16_t* Kb, const float* q_g, const float* k_g, int wave, int lane) {
    const int gw = blockIdx.x * 8 + wave, NGW = gridDim.x * 8;
    constexpr int NQ = ML * 16, NK = NB * SKV * 4, NIT = (NQ + NK) / 4;
    const int j = lane & 15, part = j >> 3, i0 = 4 * (j & 7), e0 = part * 64 + i0;
    for (int it = gw; it < NIT; it += NGW) {
        const int hr = it * 4 + (lane >> 4);
        bf16_t* base; int t; bool rope; const float* gn;
        if (hr < NQ) { const int row = hr >> 4; base = Q + (size_t)row * DM + (hr & 15) * 128; t = row & 2047; rope = true; gn = q_g; }
        else { const int r = hr - NQ, tok = r >> 2, pos = tok % SKV; base = Kb + (size_t)tok * 512 + (r & 3) * 128; rope = pos >= LC; t = pos - LC; gn = k_g; }
        const u32x2 wa = *(const u32x2*)(base + e0), wb = *(const u32x2*)(base + e0 + 32);
        float x1[4] = {bf_lo(wa.x), bf_hi(wa.x), bf_lo(wa.y), bf_hi(wa.y)}, x2[4] = {bf_lo(wb.x), bf_hi(wb.x), bf_lo(wb.y), bf_hi(wb.y)};
        float ss = 0.f;
#pragma unroll
        for (int e = 0; e < 4; ++e) ss += x1[e] * x1[e] + x2[e] * x2[e];
        ss += __shfl_xor(ss, 1); ss += __shfl_xor(ss, 2); ss += __shfl_xor(ss, 4); ss += __shfl_xor(ss, 8);
        const float rstd = rsqrtf(ss * (1.f / 128.f) + EPS);
        const float pidx = (float)(part == 0 ? (t >> 6) : (t & 63));
#pragma unroll
        for (int e = 0; e < 4; ++e) {
            float a1 = x1[e] * rstd * gn[e0 + e], a2 = x2[e] * rstd * gn[e0 + 32 + e];
            if (rope) { const float f = __builtin_amdgcn_exp2f(-(float)(i0 + e) * (13.287712379549449f / 32.f)), rev = pidx * f * 0.15915494309189535f, cs = __builtin_amdgcn_cosf(rev), sn = __builtin_amdgcn_sinf(rev);
                const float o1 = a1 * cs - a2 * sn, o2 = a2 * cs + a1 * sn; a1 = o1; a2 = o2; }
            x1[e] = a1; x2[e] = a2;
        }
        u32x2 oa, ob; oa.x = cvt_pk_bf16(x1[0], x1[1]); oa.y = cvt_pk_bf16(x1[2], x1[3]); ob.x = cvt_pk_bf16(x2[0], x2[1]); ob.y = cvt_pk_bf16(x2[2], x2[3]);
        *(u32x2*)(base + e0) = oa; *(u32x2*)(base + e0 + 32) = ob;
    }
}

__device__ __forceinline__ void scan_phase(const Args& a, const float* S, bf16_t* A2, int tid) {
    const float *a_re = a.in[13], *a_im = a.in[14], *log_dt = a.in[15];
    for (int ch = blockIdx.x * 512 + tid; ch < NB * 64 * 2 * 64; ch += gridDim.x * 512) {
        const int p = ch & 63, dir = (ch >> 6) & 1, g = (ch >> 7) & 63, b = ch >> 13;
        const float dt = expf(log_dt[dir * 64 + g]), ar = a_re[(dir * 64 + g) * 64 + p], ai = a_im[(dir * 64 + g) * 64 + p];
        const float x = ar * dt, y = ai * dt, mag = expf(x);
        f32x2 lb = (f32x2){mag * cosf(y), mag * sinf(y)};
        lb = cmul(lb, lb); lb = cmul(lb, lb); lb = cmul(lb, lb); lb = cmul(lb, lb);
        const float* Sp = S + ((size_t)(g * SROWS + b * NCH) * 256 + dir * 128 + 2 * p);
        bf16_t* Ap = A2 + ((size_t)(g * SROWS_PAD + b * NCH) * 512 + 256 + dir * 128 + 2 * p);
        f32x2 h = (f32x2){0.f, 0.f};
#pragma unroll 8
        for (int i = 0; i < NCH; ++i) {
            const int c = dir == 0 ? i : (i < 16 ? 15 - i : 159 - i);
            const f32x2 s = *(const f32x2*)(Sp + (size_t)c * 256);
            *(unsigned*)(Ap + (size_t)c * 512) = cvt_pk_bf16(h.x, h.y);
            h = cmul(lb, h) + s;
        }
    }
}


#define XB_TMO      128
#define XB_XCNT(j)  (256  + 64 * (j))
#define XB_XSUB(j)  (1280 + 64 * (j))
#define XB_XGEN(j)  (2304 + 64 * (j))
#define XB_TOP      3328
#define XB_TOPGEN   3392
#define XCD_BAR_WORDS 3456
#define XB_SPIN_CAP (1u << 18)
__device__ __forceinline__ unsigned xb_ld(unsigned* p)              { return __hip_atomic_load(p, __ATOMIC_RELAXED, __HIP_MEMORY_SCOPE_AGENT); }
__device__ __forceinline__ unsigned xb_add(unsigned* p, unsigned v) { return __hip_atomic_fetch_add(p, v, __ATOMIC_RELAXED, __HIP_MEMORY_SCOPE_AGENT); }
__device__ __forceinline__ unsigned xb_xcc_id() { return (unsigned)__builtin_amdgcn_s_getreg((3 << 11) | 20) & 0xFu; }
#define XB_SPIN(cond, bar) do { unsigned _sp = 0; while (cond) { __builtin_amdgcn_s_sleep(1); \
    if ((++_sp & 255u) == 0u) { if (xb_ld(&(bar)[XB_TMO])) break; if (_sp > XB_SPIN_CAP) { atomicAdd(&(bar)[XB_TMO], 1u); break; } } } } while (0)
struct XcdBarrier { unsigned* bar; unsigned x; volatile LAS unsigned* st; };
__device__ __forceinline__ XcdBarrier xcd_barrier_post(unsigned* bar, volatile LAS unsigned* st) {
    XcdBarrier b; b.bar = bar; b.x = xb_xcc_id(); b.st = st;
    if (threadIdx.x == 0) (void)xb_add(&bar[XB_XCNT(b.x)], 1u);
    return b;
}
__device__ __forceinline__ void xcd_barrier_complete(unsigned* bar, unsigned x, unsigned& nloc, unsigned& nx) {
    const unsigned G = gridDim.x * gridDim.y * gridDim.z;
    unsigned sum, cnt, mine, sp = 0u;
    for (;;) {
        sum = 0u; cnt = 0u; mine = 0u;
#pragma unroll
        for (unsigned j = 0; j < 16; ++j) { const unsigned c = xb_ld(&bar[XB_XCNT(j)]); sum += c; cnt += (c > 0u) ? 1u : 0u; mine = (j == x) ? c : mine; }
        if (sum == G) break;
        __builtin_amdgcn_s_sleep(1);
        if ((++sp & 255u) == 0u) { if (xb_ld(&bar[XB_TMO])) break; if (sp > XB_SPIN_CAP) { atomicAdd(&bar[XB_TMO], 1u); break; } }
    }
    nloc = mine > 0u ? mine : 1u; nx = cnt > 0u ? cnt : 1u;
}
__device__ __forceinline__ void xcd_barrier(const XcdBarrier& b) {
    asm volatile("s_waitcnt vmcnt(0)" ::: "memory");
    __syncthreads();
    if (threadIdx.x == 0) {
        unsigned* bar = b.bar;
        __builtin_amdgcn_s_waitcnt(0);
        unsigned nloc = b.st[0], nx = b.st[1];
        if (nloc == 0u) { xcd_barrier_complete(bar, b.x, nloc, nx); b.st[0] = nloc; b.st[1] = nx; }
        const unsigned old = xb_add(&bar[XB_XSUB(b.x)], 1u);
        const unsigned gen = old / nloc;
        if (old + 1u == (gen + 1u) * nloc) {
            __builtin_amdgcn_fence(__ATOMIC_RELEASE, "agent");
            asm volatile("s_waitcnt vmcnt(0)" ::: "memory");
            const unsigned og = xb_add(&bar[XB_TOP], 1u);
            const unsigned tg = og / nx;
            if (og + 1u == (tg + 1u) * nx) xb_add(&bar[XB_TOPGEN], 1u);
            else XB_SPIN(xb_ld(&bar[XB_TOPGEN]) == tg, bar);
            __builtin_amdgcn_fence(__ATOMIC_ACQUIRE, "agent");
            xb_add(&bar[XB_XGEN(b.x)], 1u);
            asm volatile("s_waitcnt vmcnt(0)" ::: "memory");
        } else {
            XB_SPIN(xb_ld(&bar[XB_XGEN(b.x)]) == gen, bar);
            __builtin_amdgcn_fence(__ATOMIC_ACQUIRE, "agent");
            asm volatile("s_waitcnt vmcnt(0)" ::: "memory");
        }
    }
    __syncthreads();
}

#ifndef REP_0
#define REP_0 1
#endif
#ifndef REP_1
#define REP_1 1
#endif
#ifndef REP_2
#define REP_2 1
#endif
#ifndef REP_3
#define REP_3 1
#endif
#ifndef REP_4
#define REP_4 1
#endif
#ifndef REP_5
#define REP_5 1
#endif
#ifndef REP_6
#define REP_6 1
#endif
#ifndef REP_7
#define REP_7 1
#endif
#ifndef REP_8
#define REP_8 1
#endif
#ifndef REP_9
#define REP_9 1
#endif
#ifndef REP_10
#define REP_10 1
#endif
#ifndef REP_11
#define REP_11 1
#endif
#ifndef REP_12
#define REP_12 1
#endif
#ifndef REP_13
#define REP_13 1
#endif
#ifndef REP_14
#define REP_14 1
#endif
#ifndef ATT_REP
#define ATT_REP 1
#endif
#ifndef UREP_3
#define UREP_3 1
#endif
#ifndef UREP_11
#define UREP_11 1
#endif
#ifndef UREP_13
#define UREP_13 1
#endif
constexpr int NPH = 15;
template <bool COOP>
__global__ void __launch_bounds__(512) mega(Args a) {
    __builtin_assume(__builtin_amdgcn_workitem_id_y() == 0); __builtin_assume(__builtin_amdgcn_workitem_id_z() == 0);
    extern __shared__ __attribute__((aligned(16))) unsigned char lds_raw[];
    LAS unsigned char* lds = (LAS unsigned char*)lds_raw;
    const int tid = threadIdx.x, lane = tid & 63, wave = __builtin_amdgcn_readfirstlane(tid >> 6);
    const int G = gridDim.x, bx = blockIdx.x;
    unsigned char* ws = a.ws;
    float* MOD = (float*)(ws + WS_MOD);
    bf16_t* H = (bf16_t*)(ws + WS_H); bf16_t* ACT = (bf16_t*)(ws + WS_ACT); bf16_t* D1 = (bf16_t*)(ws + WS_X1); bf16_t* D2 = D1 + (size_t)ML * DM;
    bf16_t* Qb = (bf16_t*)(ws + WS_Q); bf16_t* Kb = (bf16_t*)(ws + WS_K); bf16_t* Vb = (bf16_t*)(ws + WS_V);
    bf16_t* A2 = (bf16_t*)(ws + WS_A2); float* Sst = (float*)(ws + WS_S);
    bf16_t* GATE = (bf16_t*)(ws + WS_GATE); bf16_t* YG = (bf16_t*)(ws + WS_YG); bf16_t* Y2 = (bf16_t*)(ws + WS_AY); bf16_t* MERGED = (bf16_t*)(ws + WS_MERGED);
    const int lo = a.ph_lo, hi = a.ph_hi;
#define IN(k) (lo <= (k) && (k) < hi)
#define SEAM(k) do { if (COOP && IN(k) && IN((k) + 1)) { if ((k) == 0) cg::this_grid().sync(); else xcd_barrier(xbar); } } while (0)
    XcdBarrier xbar; xbar.bar = (unsigned*)(ws + WS_BAR); xbar.x = 0; xbar.st = nullptr;
    if (COOP) { volatile LAS unsigned* st = (volatile LAS unsigned*)(lds + LDS_XB_OFF); if (tid < 4) st[tid] = 0u; __syncthreads(); xbar = xcd_barrier_post((unsigned*)(ws + WS_BAR), st); }

    if (IN(0)) for (int rep_ = 0; rep_ < REP_0; ++rep_) { mod_phase(a, MOD, lds, tid); if (G != 256) ssm_params_phase(a, ws, lds, tid, bx, 256, G); weights_phase(a, ws, lds, wave, lane); }
    SEAM(0);
    if (IN(1)) for (int rep_ = 0; rep_ < REP_1; ++rep_) norm_phase<false, false>(a.in[0], a.in[2], a.in[6], MOD, 0, DM, H, MT, wave, lane);
    SEAM(1);
    if (IN(2)) for (int rep_ = 0; rep_ < REP_2; ++rep_) { pg8::Gemm g{H, (const bf16_t*)(ws + WS_W1GU), DM, DM, DM}; pg8::RectOrder S; S.init(MT / 256, 2 * DFF / 256, G, bx);
        pg8::EpiSwiGLU E{ACT}; pg8::gemm_phase(lds, g, S, E);
        if (G == 256 && bx >= 48 && bx < 176) ssm_params_phase(a, ws, lds, tid, bx - 48, bx - 47, 1); }
    SEAM(2);
    if (IN(3)) for (int rep_ = 0; rep_ < REP_3; ++rep_) {
        { pg8::Gemm g{ACT + (size_t)ML * DFF, (const bf16_t*)(ws + WS_W1D), DFF, DFF, 1408}; pg8::CtxSplitOrder S{G, bx};
          pg8::EpiPartial E{Sst}; pg8::gemm_phase(lds, g, S, E); }
        { pg8::Gemm g{ACT, (const bf16_t*)(ws + WS_W1D), DFF, DFF, DFF}; pg8::RectOrder S; S.init(ML / 256, DM / 256, G, bx); S.rep = UREP_3;
          pg8::EpiDelta<false> E{nullptr, D1, MOD, 2 * DM, 0.5f}; pg8::gemm_phase(lds, g, S, E); } }
    SEAM(3);
    if (IN(4)) for (int rep_ = 0; rep_ < REP_4; ++rep_) norm_phase<true, true>(a.in[0], a.in[2], a.in[6] + DM, MOD, 3 * DM, 4 * DM, H, MT, wave, lane, Sst, D1);
    SEAM(4);
    if (IN(5)) for (int rep_ = 0; rep_ < REP_5; ++rep_) { pg8::Gemm g{H, (const bf16_t*)(ws + WS_WIN), DM, DM, DM}; pg8::InProjOrder S; S.r0.init(ML / 256, INW / 256, G, bx); S.G = G; S.c = bx;
        pg8::EpiInProj E{Kb, Vb, A2, Qb, GATE}; pg8::gemm_phase(lds, g, S, E);
        if (G == 256 && bx >= 32 && bx < 160) ssm_params_phase(a, ws, lds, tid, 128 + bx - 32, 129 + bx - 32, 1); }
    SEAM(5);
    if (IN(6)) for (int rep_ = 0; rep_ < REP_6; ++rep_) { qknorm_phase(Qb, Kb, a.in[11], a.in[12], wave, lane);
        pg8::Gemm g{A2, (const bf16_t*)(ws + WS_WST), 512, 256, 256}; pg8::BatchOrder S{G, bx}; pg8::EpiState E{Sst}; pg8::gemm_phase(lds, g, S, E); }
    SEAM(6);
    if (IN(7)) for (int rep_ = 0; rep_ < REP_7; ++rep_) scan_phase(a, Sst, A2, tid);
    SEAM(7);
    if (IN(8)) for (int rep_ = 0; rep_ < REP_8; ++rep_) { { pg8::Gemm g{A2, (const bf16_t*)(ws + WS_WY), 512, 512, 512}; pg8::BatchOrder S{G, bx}; pg8::EpiSsmOut E{YG}; pg8::gemm_phase(lds, g, S, E); }
        for (int it_ = bx; it_ < ATT_REP * NB * 16 * (SEQ / 256); it_ += G) {
            const int it = it_ & 511, qb = it & 7, h = (it >> 3) & 15, b = it >> 7;
            bf16_t* q = Qb + ((size_t)(b * SEQ + qb * 256) * DM + h * 128);
            const size_t k0 = (size_t)b * SKV * 512 + (h >> 2) * 128;
            att::attn_dense_body(q, Kb + k0, Vb + k0, (bf16_t*)(ws + WS_AY) + ((size_t)(b * SEQ + qb * 256) * LDAY + h * 128), SKV, (char*)lds_raw);
        } }
    SEAM(8);
    if (IN(9)) for (int rep_ = 0; rep_ < REP_9; ++rep_) { pg8::Gemm g{YG, (const bf16_t*)(ws + WS_WGLU), SSMW, SSMW, SSMW}; pg8::RectOrder S; S.init(ML / 256, SSMW / 256, G, bx);
        pg8::EpiGlu E{YG, a.in[22], Y2}; pg8::gemm_phase(lds, g, S, E); }
    SEAM(9);
    if (IN(10)) for (int rep_ = 0; rep_ < REP_10; ++rep_) { pg8::MergeOrder S; S.r.init(ML / 256, DM / 256, G, bx);
        { pg8::Gemm g{(const bf16_t*)(ws + WS_AY), (const bf16_t*)(ws + WS_WBRA), LDAY, LDAY, LDAY}; pg8::EpiMergeF E{GATE, MERGED}; pg8::gemm_phase(lds, g, S, E); } }
    SEAM(10);
    if (IN(11)) for (int rep_ = 0; rep_ < REP_11; ++rep_) { pg8::Gemm g{MERGED, (const bf16_t*)(ws + WS_WOUT), DM, DM, DM}; pg8::RectOrder S; S.init(ML / 256, DM / 256, G, bx); S.rep = UREP_11;
        pg8::EpiDelta<true> E{D1, D2, MOD, 5 * DM, 1.0f}; pg8::gemm_phase(lds, g, S, E); }
    SEAM(11);
    if (IN(12)) for (int rep_ = 0; rep_ < REP_12; ++rep_) norm_phase<false, true>(a.in[0], a.in[0], a.in[6] + 2 * DM, MOD, 6 * DM, 7 * DM, H, ML, wave, lane, nullptr, D2);
    SEAM(12);
    if (IN(13)) for (int rep_ = 0; rep_ < REP_13; ++rep_) { pg8::Gemm g{H, (const bf16_t*)(ws + WS_W2GU), DM, DM, DM}; pg8::RectOrder S; S.init(ML / 256, 2 * DFF / 256, G, bx); S.rep = UREP_13;
        pg8::EpiSwiGLU E{ACT}; pg8::gemm_phase(lds, g, S, E);
#ifdef PROBE_NULL
        { pg8::EpiNull E2{(float*)(ws + WS_S)}; pg8::gemm_phase(lds, g, S, E2); }
#endif
        }
    SEAM(13);
    if (IN(14)) for (int rep_ = 0; rep_ < REP_14; ++rep_) { pg8::Gemm g{ACT, (const bf16_t*)(ws + WS_W2D), DFF, DFF, DFF}; pg8::RectOrder S; S.init(ML / 256, DM / 256, G, bx);
        pg8::EpiFinal E{a.in[0], D2, a.out, MOD, 8 * DM, 0.5f}; pg8::gemm_phase(lds, g, S, E); }
#undef IN
#undef SEAM
}

extern "C" void kernel_launch(void* const* d_in, const int* in_sizes, int n_in, void* d_out, int out_size, void* d_ws, size_t ws_size, hipStream_t stream) {
    static int grid = 0;
    if (grid == 0) {
        if (n_in != 29 || out_size != ML * DM || ws_size < WS_END) { fprintf(stderr, "kernel_launch: unexpected shapes: n_in %d out %d ws %zu (need %zu)\n", n_in, out_size, ws_size, (size_t)WS_END); grid = -1; return; }
        int dev = 0, cus = 0, per_cu = 0;
        if (hipGetDevice(&dev) != hipSuccess || hipDeviceGetAttribute(&cus, hipDeviceAttributeMultiprocessorCount, dev) != hipSuccess) { fprintf(stderr, "kernel_launch: device query failed\n"); grid = -1; return; }
        const void* fn = (const void*)mega<(bool)MK_COOP>;
        if (hipFuncSetAttribute(fn, hipFuncAttributeMaxDynamicSharedMemorySize, LDS_BYTES) != hipSuccess) { fprintf(stderr, "kernel_launch: hipFuncSetAttribute failed\n"); grid = -1; return; }
        if (hipOccupancyMaxActiveBlocksPerMultiprocessor(&per_cu, fn, 512, LDS_BYTES) != hipSuccess || per_cu < 1) { fprintf(stderr, "kernel_launch: occupancy query says %d blocks/CU\n", per_cu); grid = -1; return; }
        grid = cus;
        if (grid > 256) grid = 256;
    }
    if (grid < 0) return;
    Args a{};
    for (int i = 0; i < 29; ++i) a.in[i] = (const float*)d_in[i];
    a.out = (float*)d_out; a.ws = (unsigned char*)d_ws;
#if MK_COOP
    a.ph_lo = 0; a.ph_hi = NPH;
    if (hipMemsetAsync((char*)d_ws + WS_BAR, 0, XCD_BAR_WORDS * 4, stream) != hipSuccess) { fprintf(stderr, "kernel_launch: memset failed\n"); return; }
    void* args[] = {&a};
    hipError_t e = hipLaunchCooperativeKernel((const void*)mega<true>, dim3(grid), dim3(512), args, LDS_BYTES, stream);
    if (e != hipSuccess) fprintf(stderr, "kernel_launch: cooperative launch failed: %s (grid %d)\n", hipGetErrorString(e), grid);
#else
    for (int k = 0; k < NPH; ++k) { a.ph_lo = k; a.ph_hi = k + 1; hipLaunchKernelGGL(mega<false>, dim3(grid), dim3(512), LDS_BYTES, stream, a); }
    hipError_t e = hipPeekAtLastError();
    if (e != hipSuccess) fprintf(stderr, "kernel_launch: launch failed: %s\n", hipGetErrorString(e));
#endif
}
```

```cpp
#include <hip/hip_runtime.h>
#include <hip/hip_cooperative_groups.h>
#include <cstdio>
#include <cstdint>
namespace cg = cooperative_groups;

#ifndef MK_COOP
#define MK_COOP 1
#endif

#define LAS __attribute__((address_space(3)))
typedef unsigned short bf16_t;
typedef short bf16x8 __attribute__((ext_vector_type(8)));
typedef short s16x4 __attribute__((ext_vector_type(4)));
typedef float f32x4 __attribute__((ext_vector_type(4)));
typedef float f32x2 __attribute__((ext_vector_type(2)));
typedef float f32x16 __attribute__((ext_vector_type(16)));
typedef unsigned u32x4 __attribute__((ext_vector_type(4)));
typedef unsigned u32x2 __attribute__((ext_vector_type(2)));

constexpr int DM = 2048, NB = 4, SEQ = 2048, LC = 256, ML = NB * SEQ  , MC = NB * LC  , MT = ML + MC  ;
constexpr int DFF = 5632, INW = 8192, SKV = SEQ + LC  , NMOD = 9 * DM  , SSMW = 1024;
constexpr int NCH = SKV / 16  , SROWS = NB * NCH  , SROWS_PAD = 768;
constexpr float EPS = 1e-6f;

constexpr size_t al256(size_t x) { return (x + 255) / 256 * 256; }
constexpr size_t WS_W1GU = 0;
constexpr size_t WS_W1D  = WS_W1GU + al256((size_t)2 * DFF * DM * 2);
constexpr size_t WS_WIN  = WS_W1D + al256((size_t)DM * DFF * 2);
constexpr size_t WS_WGLU = WS_WIN + al256((size_t)INW * DM * 2);
constexpr size_t WS_WBRA = WS_WGLU + al256((size_t)SSMW * SSMW * 2);
constexpr size_t WS_WBRS = WS_WBRA + al256((size_t)DM * DM * 2);
constexpr size_t WS_WOUT = WS_WBRS + al256((size_t)DM * SSMW * 2);
constexpr size_t WS_W2GU = WS_WOUT + al256((size_t)DM * DM * 2);
constexpr size_t WS_W2D  = WS_W2GU + al256((size_t)2 * DFF * DM * 2);
constexpr size_t WS_MOD  = WS_W2D + al256((size_t)DM * DFF * 2);
constexpr size_t WS_H    = WS_MOD + al256((size_t)5 * NMOD * 4);
constexpr size_t WS_ACT  = WS_H + al256((size_t)MT * DM * 2);
constexpr size_t WS_X1   = WS_ACT + al256((size_t)MT * DFF * 2);
constexpr size_t WS_Q    = WS_X1 + al256((size_t)MT * DM * 4);
constexpr size_t WS_K    = WS_Q + al256((size_t)ML * DM * 2);
constexpr size_t WS_V    = WS_K + al256((size_t)NB * SKV * 512 * 2);
constexpr size_t WS_A2   = WS_V + al256((size_t)NB * SKV * 512 * 2);
constexpr size_t WS_S    = WS_A2 + al256((size_t)64 * SROWS_PAD * 512 * 2);
constexpr size_t WS_WY   = WS_S + al256((size_t)64 * SROWS * 256 * 4);
constexpr size_t WS_WST  = WS_WY + al256((size_t)64 * 256 * 512 * 2);
constexpr size_t WS_BAR  = WS_WST + al256((size_t)64 * 256 * 256 * 2);
constexpr size_t WS_END  = WS_BAR + al256((size_t)3456 * 4);
constexpr size_t WS_AY   = WS_H;
constexpr size_t WS_GATE = WS_ACT + 19922944;
constexpr size_t WS_YG   = WS_GATE + (size_t)ML * 4096 * 2;
static_assert(WS_YG + (size_t)ML * SSMW * 2 <= WS_X1 && WS_AY + (size_t)ML * 3072 * 2 <= WS_GATE && WS_GATE % 256 == 0, "ACT aliases");
constexpr int LDAY = 3072;
constexpr size_t WS_MERGED = WS_Q;

constexpr int LDS_BYTES = 131072 + 16;
constexpr int LDS_XB_OFF = 131072;

typedef __bf16 bf16v2_t __attribute__((ext_vector_type(2)));
__device__ __forceinline__ unsigned cvt_pk_bf16(float lo, float hi) { const f32x2 v = (f32x2){lo, hi}; const bf16v2_t b = __builtin_convertvector(v, bf16v2_t); return __builtin_bit_cast(unsigned, b); }
__device__ __forceinline__ float bf_lo(unsigned w) { return __uint_as_float(w << 16); }
__device__ __forceinline__ float bf_hi(unsigned w) { return __uint_as_float(w & 0xffff0000u); }
__device__ __forceinline__ float wave_sum(float v) {
#pragma unroll
    for (int o = 1; o < 64; o <<= 1) v += __shfl_xor(v, o);
    return v;
}
__device__ __forceinline__ float sigmoid_f(float x) { return __builtin_amdgcn_rcpf(1.f + __builtin_amdgcn_exp2f(-1.4426950408889634f * x)); }
__device__ __forceinline__ float silu_f(float x) { return x * __builtin_amdgcn_rcpf(1.f + __builtin_amdgcn_exp2f(-1.4426950408889634f * x)); }
__device__ __forceinline__ float gelu_tanh_f(float x) { const float u = 0.7978845608028654f * (x + 0.044715f * x * x * x); return x * __builtin_amdgcn_rcpf(1.f + __builtin_amdgcn_exp2f(-2.8853900817779268f * u)); }
__device__ __forceinline__ f32x2 cmul(f32x2 a, f32x2 b) { return (f32x2){a.x * b.x - a.y * b.y, a.x * b.y + a.y * b.x}; }
#define LDS_WAIT() asm volatile("s_waitcnt lgkmcnt(0)" ::: "memory")

namespace pg8 {
constexpr int BM = 256, BK = 64, HALF = 128, HTB = HALF * BK * 2, STAGE_BYTES = 8 * HTB, NXCD = 8, WGM = 4;
__host__ __device__ __forceinline__ int lds_byte(int r, int c) { const int st = (r >> 4) * 2 + (c >> 5), rr = r & 15, cc = c & 31, ob = rr * 64 + cc * 2; return st * 1024 + (ob ^ (((ob >> 9) & 1) << 5)); }
__host__ __device__ __forceinline__ void stage_rc(int b, int& R, int& C) { const int st = b / 1024, sb = b % 1024, swz = sb ^ (((sb >> 9) & 1) << 5); R = (st >> 1) * 16 + swz / 64; C = (st & 1) * 32 + (swz % 64) / 2; }
__host__ __device__ __forceinline__ int perm32(int rho) { const int n = rho >> 4, i = rho & 15; return 8 * (i >> 2) + 4 * n + (i & 3); }

struct Unit { int pm, pn, ko, sg; };
struct Gemm { const bf16_t* A; const bf16_t* Bt; int lda, ldb, K; };

struct RectOrder {
    int nM, nN, nwg, G, c, pm0, pn0, rep = 1;
    __device__ void init(int nM_, int nN_, int G_, int c_, int pm0_ = 0, int pn0_ = 0) { nM = nM_; nN = nN_; nwg = nM * nN; G = G_; c = c_; pm0 = pm0_; pn0 = pn0_; }
    __device__ bool map(long L, Unit& u) const {
        if (L >= (long)nwg * rep) return false;
        int wgid = (int)(L % nwg); { const int q = nwg / NXCD, r = nwg % NXCD, xcd = wgid % NXCD, off = wgid / NXCD; wgid = (xcd < r ? xcd * (q + 1) : r * (q + 1) + (xcd - r) * q) + off; }
        const int nig = WGM * nN, gid = wgid / nig, fm = gid * WGM, gsz = (nM - fm) < WGM ? (nM - fm) : WGM;
        u.pm = pm0 + fm + ((wgid % nig) % gsz); u.pn = pn0 + (wgid % nig) / gsz; u.ko = 0; u.sg = 0; return true;
    }
    __device__ bool next(int i, Unit& u) const { return map((long)i * G + c, u); }
};
struct InProjOrder {
    RectOrder r0; int G, c;
    __device__ bool next(int i, Unit& u) const {
        const long L = (long)i * G + c;
        if (L < r0.nwg) return r0.map(L, u);
        const int l2 = (int)(L - r0.nwg); if (l2 >= 32) return false;
        u.pm = 32 + (l2 & 3); u.pn = l2 >> 2; u.ko = 0; u.sg = 0; return true;
    }
};
struct BatchOrder {
    int G, c;
    __device__ bool next(int i, Unit& u) const { const long L = (long)i * G + c; if (L >= 192) return false; u.pm = (int)L; u.pn = (int)L / 3; u.ko = 0; u.sg = 0; return true; }
};

struct CtxSplitOrder {
    int G, c;
    __device__ bool next(int i, Unit& u) const { const long L = (long)i * G + c; if (L >= 128) return false; u.pm = (int)L & 3; u.pn = ((int)L >> 2) & 7; u.ko = ((int)L >> 5) * (1408 * 2); u.sg = 0; return true; }
};

struct MergeOrder {
    RectOrder r;
    __device__ bool next(int i, Unit& u) const { if (!r.map((long)(i >> 1) * r.G + r.c, u)) return false; const int rev = (r.c >> 3) & 1; u.sg = 1 + (i & 1); u.ko = ((i & 1) ^ rev) ? 2048 * 2 : 0; return true; }
};

template <class Epi, class Sched>
__device__ __forceinline__ void gemm_phase(LAS unsigned char* lds, const Gemm g, const Sched& S, const Epi& E) {
    const int tid = threadIdx.x, wid = __builtin_amdgcn_readfirstlane(tid >> 6), lane = tid & 63, wr = wid >> 2, wc = wid & 3, fr = lane & 15, fq = lane >> 4;
    const int K = g.K, nt = K / BK, lda = g.lda, ldb = g.ldb;
    unsigned voffA[2], voffB[2];
#pragma unroll
    for (int i = 0; i < 2; ++i) { int R, C; stage_rc(tid * 16 + i * 8192, R, C); const int Rb = Epi::PERM ? ((R & ~31) + perm32(R & 31)) : R;
        voffA[i] = (unsigned)(R * lda + C) * 2u; voffB[i] = (unsigned)(Rb * ldb + C) * 2u; }
    const size_t kstep = (size_t)(BK * 2);
    const size_t hstepA = (size_t)HALF * lda * 2, hstepB = (size_t)HALF * ldb * 2;
    const size_t tstepA = 2 * hstepA, tstepB = 2 * hstepB;
    const unsigned ldsw = (unsigned)wid * 1024u;
    const int aoff = lds_byte(wr * 64 + fr, fq * 8), boff = lds_byte(wc * 32 + fr, fq * 8);
#define PG8_SA(b, h) (((b) * 2 + (h)) * HTB)
#define PG8_SB(b, h) ((4 + (b) * 2 + (h)) * HTB)
#define PG8_STAGE(bufoff, gbase, voff) do { _Pragma("unroll") for (int _i = 0; _i < 2; ++_i) \
        __builtin_amdgcn_global_load_lds((const unsigned*)((const char*)(gbase) + (voff)[_i]), (LAS unsigned*)(lds + (bufoff) + ldsw + _i * 8192), 16, 0, 0); } while (0)
#define PG8_LDA(dst, b, h) do { _Pragma("unroll") for (int m = 0; m < 4; ++m) _Pragma("unroll") for (int k = 0; k < 2; ++k) dst[m][k] = *(const LAS bf16x8*)(lds + PG8_SA(b, h) + aoff + m * 2048 + k * 1024); } while (0)
#define PG8_LDB(dst, b, h) do { _Pragma("unroll") for (int n = 0; n < 2; ++n) _Pragma("unroll") for (int k = 0; k < 2; ++k) dst[n][k] = *(const LAS bf16x8*)(lds + PG8_SB(b, h) + boff + n * 2048 + k * 1024); } while (0)
#define PG8_MMA(ai, bj, At, Bt) do { __builtin_amdgcn_s_setprio(1); _Pragma("unroll") for (int m = 0; m < 4; ++m) _Pragma("unroll") for (int n = 0; n < 2; ++n) _Pragma("unroll") for (int k = 0; k < 2; ++k) \
        acc[ai][bj][m][n] = __builtin_amdgcn_mfma_f32_16x16x32_bf16(Bt[n][k], At[m][k], acc[ai][bj][m][n], 0, 0, 0); __builtin_amdgcn_s_setprio(0); } while (0)
#define PG8_WAIT_V(n) asm volatile("s_waitcnt vmcnt(" #n ")" ::: "memory")
#define PG8_WAIT_L(n) asm volatile("s_waitcnt lgkmcnt(" #n ")" ::: "memory")
#define PG8_BAR __builtin_amdgcn_s_barrier()
#define PG8_SCHED __builtin_amdgcn_sched_barrier(0)
    Unit cur, nxt; int ui = 0;
    if (!S.next(0, cur)) return;
    f32x4 acc[2][2][4][2];
#pragma unroll
    for (int a = 0; a < 2; ++a)
#pragma unroll
        for (int b = 0; b < 2; ++b)
#pragma unroll
            for (int m = 0; m < 4; ++m)
#pragma unroll
                for (int n = 0; n < 2; ++n) acc[a][b][m][n] = (f32x4){0.f, 0.f, 0.f, 0.f};
    bf16x8 At[4][2], B0[2][2], B1[2][2];
    const char* cA = (const char*)g.A + (size_t)cur.pm * tstepA + cur.ko; const char* cB = (const char*)g.Bt + (size_t)cur.pn * tstepB + cur.ko;
    PG8_STAGE(PG8_SB(0, 0), cB, voffB); PG8_STAGE(PG8_SB(0, 1), cB + hstepB, voffB); PG8_STAGE(PG8_SA(0, 0), cA, voffA); PG8_STAGE(PG8_SA(0, 1), cA + hstepA, voffA);
    if (wr == 1) PG8_BAR;
    PG8_WAIT_V(2); PG8_BAR;
    PG8_STAGE(PG8_SB(1, 0), cB + kstep, voffB); PG8_STAGE(PG8_SA(1, 0), cA + kstep, voffA); PG8_STAGE(PG8_SB(1, 1), cB + hstepB + kstep, voffB);
    PG8_WAIT_V(6); PG8_BAR;
    for (;;) {
        const bool has_next = S.next(ui + 1, nxt);
        const char* nA = has_next ? (const char*)g.A + (size_t)nxt.pm * tstepA + nxt.ko : cA; const char* nB = has_next ? (const char*)g.Bt + (size_t)nxt.pn * tstepB + nxt.ko : cB;
#define PG8_ITER \
            const bool last = (t == nt_u - 2); \
            const char* a1 = cA + (size_t)(t + 1) * kstep; \
            const char* a2 = last ? nA : cA + (size_t)(t + 2) * kstep; const char* b2 = last ? nB : cB + (size_t)(t + 2) * kstep; \
            const char* a3 = a2 + kstep; const char* b3 = b2 + kstep; \
            PG8_LDB(B0, 0, 0); PG8_LDB(B1, 0, 1); PG8_SCHED; PG8_LDA(At, 0, 0); PG8_STAGE(PG8_SA(1, 1), a1 + hstepA, voffA); \
            PG8_WAIT_V(8); PG8_WAIT_L(0); PG8_BAR; PG8_MMA(0, 0, At, B0); PG8_MMA(0, 1, At, B1); PG8_BAR; PG8_SCHED; \
            PG8_LDA(At, 0, 1); PG8_STAGE(PG8_SB(0, 0), b2, voffB); PG8_STAGE(PG8_SB(0, 1), b2 + hstepB, voffB); PG8_STAGE(PG8_SA(0, 0), a2, voffA); \
            PG8_WAIT_V(8); PG8_WAIT_L(0); PG8_BAR; PG8_MMA(1, 0, At, B0); PG8_MMA(1, 1, At, B1); PG8_BAR; PG8_SCHED; \
            PG8_LDB(B0, 1, 0); PG8_LDB(B1, 1, 1); PG8_SCHED; PG8_LDA(At, 1, 0); PG8_STAGE(PG8_SA(0, 1), a2 + hstepA, voffA); \
            PG8_WAIT_V(8); PG8_WAIT_L(0); PG8_BAR; PG8_MMA(0, 0, At, B0); PG8_MMA(0, 1, At, B1); PG8_BAR; PG8_SCHED; \
            PG8_LDA(At, 1, 1); PG8_STAGE(PG8_SB(1, 0), b3, voffB); PG8_STAGE(PG8_SB(1, 1), b3 + hstepB, voffB); PG8_STAGE(PG8_SA(1, 0), a3, voffA); \
            PG8_WAIT_V(8); PG8_WAIT_L(0); PG8_BAR; PG8_MMA(1, 0, At, B0); PG8_MMA(1, 1, At, B1); PG8_BAR; PG8_SCHED;
        const int nt_u = (Epi::MID_T >= 0) ? (cur.ko == 0 ? Epi::MID_T : nt - Epi::MID_T) : nt;
        for (int t = 0; t < nt_u; t += 2) { PG8_ITER }
#undef PG8_ITER
        if (wr == 0) PG8_BAR;
        bool keep_acc = false;
        if constexpr (Epi::MID_T >= 0) { if (cur.sg == 1) { E.mid(acc, cur, wr, wc, fr, fq); keep_acc = true; } else E(acc, cur, wr, wc, fr, fq); }
        else E(acc, cur, wr, wc, fr, fq);
        if (!has_next) break;
        if (!keep_acc) {
#pragma unroll
        for (int a = 0; a < 2; ++a)
#pragma unroll
            for (int b = 0; b < 2; ++b)
#pragma unroll
                for (int m = 0; m < 4; ++m)
#pragma unroll
                    for (int n = 0; n < 2; ++n) acc[a][b][m][n] = (f32x4){0.f, 0.f, 0.f, 0.f};
        }
        cur = nxt; cA = nA; cB = nB; ++ui;
        if (wr == 1) PG8_BAR;
    }
    PG8_WAIT_V(0);
    PG8_BAR;
#undef PG8_SA
#undef PG8_SB
#undef PG8_STAGE
#undef PG8_LDA
#undef PG8_LDB
#undef PG8_MMA
#undef PG8_WAIT_V
#undef PG8_WAIT_L
#undef PG8_BAR
#undef PG8_SCHED
}

typedef f32x4 AccT[2][2][4][2];

struct EpiSwiGLU {
    static constexpr bool PERM = true; static constexpr int MID_T = -1;
    bf16_t* O;
    __device__ __forceinline__ void operator()(const AccT& acc, const Unit& u, int wr, int wc, int fr, int fq) const {
        const int row0 = u.pm * BM + wr * 64 + fr, col0 = u.pn * 128 + wc * 32 + 8 * fq;
#pragma unroll
        for (int ai = 0; ai < 2; ++ai)
#pragma unroll
            for (int m = 0; m < 4; ++m) {
                const f32x4 g0 = acc[ai][0][m][0], g1 = acc[ai][0][m][1], u0 = acc[ai][1][m][0], u1 = acc[ai][1][m][1];
                u32x4 w;
                w.x = cvt_pk_bf16(silu_f(g0[0]) * u0[0], silu_f(g0[1]) * u0[1]); w.y = cvt_pk_bf16(silu_f(g0[2]) * u0[2], silu_f(g0[3]) * u0[3]);
                w.z = cvt_pk_bf16(silu_f(g1[0]) * u1[0], silu_f(g1[1]) * u1[1]); w.w = cvt_pk_bf16(silu_f(g1[2]) * u1[2], silu_f(g1[3]) * u1[3]);
                *(u32x4*)(O + (size_t)(row0 + ai * HALF + m * 16) * DFF + col0) = w;
            }
    }
};
struct EpiRes {
    static constexpr bool PERM = false; static constexpr int MID_T = -1;
    const float* res_lat; const float* res_ctx; float* out; const float* mod; int goff; float s;
    __device__ __forceinline__ void operator()(const AccT& acc, const Unit& u, int wr, int wc, int fr, int fq) const {
        const int row0 = u.pm * BM + wr * 64 + fr, col0 = u.pn * BM + wc * 32 + 4 * fq;
        const bool isctx = (u.pm >= ML / BM);
        const int modrow = isctx ? 4 : (u.pm >> 3);
        const float* mg = mod + (size_t)modrow * NMOD + goff + col0;
        f32x4 gv[2][2];
#pragma unroll
        for (int bj = 0; bj < 2; ++bj)
#pragma unroll
            for (int n = 0; n < 2; ++n) gv[bj][n] = *(const f32x4*)(mg + bj * HALF + n * 16) * s;
#pragma unroll
        for (int ai = 0; ai < 2; ++ai) {
            f32x4 r[4][2][2];
#pragma unroll
            for (int m = 0; m < 4; ++m) {
                const int row = row0 + ai * HALF + m * 16;
                const float* rp = (isctx ? res_ctx + (size_t)(row - ML) * DM : res_lat + (size_t)row * DM) + col0;
#pragma unroll
                for (int bj = 0; bj < 2; ++bj)
#pragma unroll
                    for (int n = 0; n < 2; ++n) r[m][bj][n] = *(const f32x4*)(rp + bj * HALF + n * 16);
            }
#pragma unroll
            for (int m = 0; m < 4; ++m) {
                float* op = out + (size_t)(row0 + ai * HALF + m * 16) * DM + col0;
#pragma unroll
                for (int bj = 0; bj < 2; ++bj)
#pragma unroll
                    for (int n = 0; n < 2; ++n) *(f32x4*)(op + bj * HALF + n * 16) = r[m][bj][n] + gv[bj][n] * acc[ai][bj][m][n];
            }
        }
    }
};
template <bool ADD> struct EpiDelta {
    static constexpr bool PERM = true; static constexpr int MID_T = -1;
    const bf16_t* Din; bf16_t* Dout; const float* mod; int goff; float s;
    __device__ __forceinline__ void operator()(const AccT& acc, const Unit& u, int wr, int wc, int fr, int fq) const {
        const int row0 = u.pm * BM + wr * 64 + fr, col0 = u.pn * BM + wc * 32 + 8 * fq;
        const float* mg = mod + (size_t)(u.pm >> 3) * NMOD + goff + col0;
        f32x4 gv[2][2];
#pragma unroll
        for (int bj = 0; bj < 2; ++bj)
#pragma unroll
            for (int n = 0; n < 2; ++n) gv[bj][n] = *(const f32x4*)(mg + bj * HALF + 4 * n) * s;
#pragma unroll
        for (int ai = 0; ai < 2; ++ai) {
            u32x4 din[4][2];
            if (ADD) {
#pragma unroll
                for (int m = 0; m < 4; ++m)
#pragma unroll
                    for (int bj = 0; bj < 2; ++bj) din[m][bj] = *(const u32x4*)(Din + (size_t)(row0 + ai * HALF + m * 16) * DM + col0 + bj * HALF);
            }
#pragma unroll
            for (int m = 0; m < 4; ++m)
#pragma unroll
                for (int bj = 0; bj < 2; ++bj) {
                    f32x4 v0 = gv[bj][0] * acc[ai][bj][m][0], v1 = gv[bj][1] * acc[ai][bj][m][1];
                    if (ADD) { const u32x4 d = din[m][bj]; v0 += (f32x4){bf_lo(d.x), bf_hi(d.x), bf_lo(d.y), bf_hi(d.y)}; v1 += (f32x4){bf_lo(d.z), bf_hi(d.z), bf_lo(d.w), bf_hi(d.w)}; }
                    u32x4 w; w.x = cvt_pk_bf16(v0[0], v0[1]); w.y = cvt_pk_bf16(v0[2], v0[3]); w.z = cvt_pk_bf16(v1[0], v1[1]); w.w = cvt_pk_bf16(v1[2], v1[3]);
                    *(u32x4*)(Dout + (size_t)(row0 + ai * HALF + m * 16) * DM + col0 + bj * HALF) = w;
                }
        }
    }
};
struct EpiFinal {
    static constexpr bool PERM = false; static constexpr int MID_T = -1;
    const float* x; const bf16_t* D; float* out; const float* mod; int goff; float s;
    __device__ __forceinline__ void operator()(const AccT& acc, const Unit& u, int wr, int wc, int fr, int fq) const {
        const int row0 = u.pm * BM + wr * 64 + fr, col0 = u.pn * BM + wc * 32 + 4 * fq;
        const float* mg = mod + (size_t)(u.pm >> 3) * NMOD + goff + col0;
        f32x4 gv[2][2];
#pragma unroll
        for (int bj = 0; bj < 2; ++bj)
#pragma unroll
            for (int n = 0; n < 2; ++n) gv[bj][n] = *(const f32x4*)(mg + bj * HALF + n * 16) * s;
#pragma unroll
        for (int ai = 0; ai < 2; ++ai)
#pragma unroll
            for (int mh = 0; mh < 2; ++mh) {
                f32x4 r[2][2][2]; u32x2 d[2][2][2];
#pragma unroll
                for (int mm = 0; mm < 2; ++mm)
#pragma unroll
                    for (int bj = 0; bj < 2; ++bj)
#pragma unroll
                        for (int n = 0; n < 2; ++n) { const size_t off = (size_t)(row0 + ai * HALF + (mh * 2 + mm) * 16) * DM + col0 + bj * HALF + n * 16;
                            r[mm][bj][n] = __builtin_nontemporal_load((const f32x4*)(x + off)); d[mm][bj][n] = *(const u32x2*)(D + off); }
#pragma unroll
                for (int mm = 0; mm < 2; ++mm)
#pragma unroll
                    for (int bj = 0; bj < 2; ++bj)
#pragma unroll
                        for (int n = 0; n < 2; ++n) { const size_t off = (size_t)(row0 + ai * HALF + (mh * 2 + mm) * 16) * DM + col0 + bj * HALF + n * 16;
                            const u32x2 dd = d[mm][bj][n];
                            *(f32x4*)(out + off) = r[mm][bj][n] + (f32x4){bf_lo(dd.x), bf_hi(dd.x), bf_lo(dd.y), bf_hi(dd.y)} + gv[bj][n] * acc[ai][bj][mh * 2 + mm][n]; }
            }
    }
};
struct EpiNull {
    static constexpr bool PERM = true; static constexpr int MID_T = -1;
    float* dummy;
    __device__ __forceinline__ void operator()(const AccT& acc, const Unit& u, int wr, int wc, int fr, int fq) const {
        f32x4 s = (f32x4){0.f, 0.f, 0.f, 0.f};
#pragma unroll
        for (int ai = 0; ai < 2; ++ai)
#pragma unroll
            for (int bj = 0; bj < 2; ++bj)
#pragma unroll
                for (int m = 0; m < 4; ++m)
#pragma unroll
                    for (int n = 0; n < 2; ++n) s += acc[ai][bj][m][n];
        if (s[0] + s[1] + s[2] + s[3] == 123456.78125f) dummy[u.pm] = s[0];
    }
};
struct EpiPartial {
    static constexpr bool PERM = false; static constexpr int MID_T = -1;
    float* P;
    __device__ __forceinline__ void operator()(const AccT& acc, const Unit& u, int wr, int wc, int fr, int fq) const {
        const int row0 = u.pm * BM + wr * 64 + fr, col0 = u.pn * BM + wc * 32 + 4 * fq;
        float* base = P + (size_t)(u.ko / (1408 * 2)) * MC * DM;
#pragma unroll
        for (int ai = 0; ai < 2; ++ai)
#pragma unroll
            for (int m = 0; m < 4; ++m) { float* op = base + (size_t)(row0 + ai * HALF + m * 16) * DM + col0;
#pragma unroll
                for (int bj = 0; bj < 2; ++bj)
#pragma unroll
                    for (int n = 0; n < 2; ++n) *(f32x4*)(op + bj * HALF + n * 16) = acc[ai][bj][m][n]; }
    }
};
struct EpiInProj {
    static constexpr bool PERM = true; static constexpr int MID_T = -1;
    bf16_t *Kb, *Vb, *A2, *Qb, *GATE;
    template <int TYPE> __device__ __forceinline__ void run(const AccT& acc, const Unit& u, int wr, int wc, int fr, int fq) const {
        const int row0 = u.pm * BM + wr * 64 + fr, colt = u.pn * BM + wc * 32 + 8 * fq;
        const bool isctx = (u.pm >= ML / BM);
#pragma unroll
        for (int ai = 0; ai < 2; ++ai)
#pragma unroll
            for (int m = 0; m < 4; ++m) {
                const int row = row0 + ai * HALF + m * 16;
                int b, pos;
                if (isctx) { const int r = row - ML; b = r >> 8; pos = r & 255; } else { b = row >> 11; pos = 256 + (row & 2047); }
#pragma unroll
                for (int bj = 0; bj < 2; ++bj) {
                    const int col = colt + bj * HALF;
                    f32x4 v0 = acc[ai][bj][m][0], v1 = acc[ai][bj][m][1];
                    bf16_t* dst;
                    if (TYPE == 0) dst = Kb + ((size_t)(b * SKV + pos) * 512 + col);
                    else if (TYPE == 1) dst = Vb + ((size_t)(b * SKV + pos) * 512 + (col - 512));
                    else if (TYPE == 2) { const int cc = col - 1024, grp = cc >> 4, c = cc & 15; dst = A2 + (((size_t)grp * SROWS_PAD + b * NCH + (pos >> 4)) * 512 + (pos & 15) * 16 + c); }
                    else if (TYPE == 3) dst = Qb + ((size_t)row * DM + (col - 2048));
                    else { dst = GATE + ((size_t)row * 4096 + (col - 4096));
#pragma unroll
                        for (int j = 0; j < 4; ++j) { v0[j] = sigmoid_f(v0[j]); v1[j] = sigmoid_f(v1[j]); } }
                    u32x4 w; w.x = cvt_pk_bf16(v0[0], v0[1]); w.y = cvt_pk_bf16(v0[2], v0[3]); w.z = cvt_pk_bf16(v1[0], v1[1]); w.w = cvt_pk_bf16(v1[2], v1[3]);
                    *(u32x4*)dst = w;
                }
            }
    }
    __device__ __forceinline__ void operator()(const AccT& acc, const Unit& u, int wr, int wc, int fr, int fq) const {
        if (u.pn < 2) run<0>(acc, u, wr, wc, fr, fq);
        else if (u.pn < 4) run<1>(acc, u, wr, wc, fr, fq);
        else if (u.pn < 8) run<2>(acc, u, wr, wc, fr, fq);
        else if (u.pn < 16) run<3>(acc, u, wr, wc, fr, fq);
        else run<4>(acc, u, wr, wc, fr, fq);
    }
};
struct EpiState {
    static constexpr bool PERM = false; static constexpr int MID_T = -1;
    float* S;
    __device__ __forceinline__ void operator()(const AccT& acc, const Unit& u, int wr, int wc, int fr, int fq) const {
        const int grp = u.pn, R0 = (u.pm - grp * 3) * BM + wr * 64 + fr, col0 = wc * 32 + 4 * fq;
#pragma unroll
        for (int ai = 0; ai < 2; ++ai)
#pragma unroll
            for (int m = 0; m < 4; ++m) {
                const int R = R0 + ai * HALF + m * 16;
                if (R < SROWS) { float* op = S + ((size_t)grp * SROWS + R) * 256 + col0;
#pragma unroll
                    for (int bj = 0; bj < 2; ++bj)
#pragma unroll
                        for (int n = 0; n < 2; ++n) *(f32x4*)(op + bj * HALF + n * 16) = acc[ai][bj][m][n]; }
            }
    }
};
struct EpiSsmOut {
    static constexpr bool PERM = true; static constexpr int MID_T = -1;
    bf16_t* YG;
    __device__ __forceinline__ void operator()(const AccT& acc, const Unit& u, int wr, int wc, int fr, int fq) const {
        const int grp = u.pn, R0 = (u.pm - grp * 3) * BM + wr * 64 + fr, n0 = wc * 32 + 8 * fq;
#pragma unroll
        for (int ai = 0; ai < 2; ++ai)
#pragma unroll
            for (int m = 0; m < 4; ++m) {
                const int R = R0 + ai * HALF + m * 16;
                const int b = R / NCH, ch = R - b * NCH;
                if (R < SROWS && ch >= 16) {
#pragma unroll
                    for (int bj = 0; bj < 2; ++bj) {
                        const int n = n0 + bj * HALF, t = n >> 4, co = n & 15;
                        const f32x4 v0 = acc[ai][bj][m][0], v1 = acc[ai][bj][m][1];
                        u32x4 w; w.x = cvt_pk_bf16(gelu_tanh_f(v0[0]), gelu_tanh_f(v0[1])); w.y = cvt_pk_bf16(gelu_tanh_f(v0[2]), gelu_tanh_f(v0[3]));
                        w.z = cvt_pk_bf16(gelu_tanh_f(v1[0]), gelu_tanh_f(v1[1])); w.w = cvt_pk_bf16(gelu_tanh_f(v1[2]), gelu_tanh_f(v1[3]));
                        *(u32x4*)(YG + ((size_t)(b * SEQ + (ch - 16) * 16 + t) * SSMW + grp * 16 + co)) = w;
                    }
                }
            }
    }
};
struct EpiGlu {
    static constexpr bool PERM = true; static constexpr int MID_T = -1;
    const bf16_t* YG; const float* bias; bf16_t* Y2;
    __device__ __forceinline__ void operator()(const AccT& acc, const Unit& u, int wr, int wc, int fr, int fq) const {
        const int row0 = u.pm * BM + wr * 64 + fr, col0 = u.pn * BM + wc * 32 + 8 * fq;
        f32x4 bv[2][2];
#pragma unroll
        for (int bj = 0; bj < 2; ++bj)
#pragma unroll
            for (int n = 0; n < 2; ++n) bv[bj][n] = *(const f32x4*)(bias + col0 + bj * HALF + 4 * n);
#pragma unroll
        for (int ai = 0; ai < 2; ++ai) {
            u32x4 yv[4][2];
#pragma unroll
            for (int m = 0; m < 4; ++m)
#pragma unroll
                for (int bj = 0; bj < 2; ++bj) yv[m][bj] = *(const u32x4*)(YG + (size_t)(row0 + ai * HALF + m * 16) * SSMW + col0 + bj * HALF);
#pragma unroll
            for (int m = 0; m < 4; ++m) {
                const size_t off = (size_t)(row0 + ai * HALF + m * 16) * SSMW + col0;
#pragma unroll
                for (int bj = 0; bj < 2; ++bj) {
                    const u32x4 y = yv[m][bj];
                    const f32x4 v0 = acc[ai][bj][m][0] + bv[bj][0], v1 = acc[ai][bj][m][1] + bv[bj][1];
                    u32x4 w;
                    w.x = cvt_pk_bf16(bf_lo(y.x) * sigmoid_f(v0[0]), bf_hi(y.x) * sigmoid_f(v0[1])); w.y = cvt_pk_bf16(bf_lo(y.y) * sigmoid_f(v0[2]), bf_hi(y.y) * sigmoid_f(v0[3]));
                    w.z = cvt_pk_bf16(bf_lo(y.z) * sigmoid_f(v1[0]), bf_hi(y.z) * sigmoid_f(v1[1])); w.w = cvt_pk_bf16(bf_lo(y.w) * sigmoid_f(v1[2]), bf_hi(y.w) * sigmoid_f(v1[3]));
                    *(u32x4*)(Y2 + (size_t)(row0 + ai * HALF + m * 16) * LDAY + 2048 + col0 + bj * HALF) = w;
                }
            }
        }
    }
};
template <int STEP> struct EpiMerge {
    static constexpr bool PERM = true; static constexpr int MID_T = -1;
    const bf16_t* GATE; float* TMP; bf16_t* MERGED;
    __device__ __forceinline__ void operator()(const AccT& acc, const Unit& u, int wr, int wc, int fr, int fq) const {
        const int row0 = u.pm * BM + wr * 64 + fr, col0 = u.pn * BM + wc * 32 + 8 * fq;
#pragma unroll
        for (int ai = 0; ai < 2; ++ai)
#pragma unroll
            for (int mh = 0; mh < 2; ++mh) {
                u32x4 gt[2][2]; f32x4 t0[2][2], t1[2][2];
#pragma unroll
                for (int mm = 0; mm < 2; ++mm)
#pragma unroll
                    for (int bj = 0; bj < 2; ++bj) {
                        const int row = row0 + ai * HALF + (mh * 2 + mm) * 16, col = col0 + bj * HALF;
                        gt[mm][bj] = *(const u32x4*)(GATE + (size_t)row * 4096 + (STEP == 1 ? 0 : 2048) + col);
                        if (STEP == 2) { const float* tp = TMP + (size_t)row * DM + col; t0[mm][bj] = *(const f32x4*)tp; t1[mm][bj] = *(const f32x4*)(tp + 4); }
                    }
#pragma unroll
                for (int mm = 0; mm < 2; ++mm)
#pragma unroll
                    for (int bj = 0; bj < 2; ++bj) {
                        const int m = mh * 2 + mm, row = row0 + ai * HALF + m * 16, col = col0 + bj * HALF;
                        const u32x4 g = gt[mm][bj];
                        const f32x4 g0 = (f32x4){bf_lo(g.x), bf_hi(g.x), bf_lo(g.y), bf_hi(g.y)}, g1 = (f32x4){bf_lo(g.z), bf_hi(g.z), bf_lo(g.w), bf_hi(g.w)};
                        if (STEP == 1) { float* tp = TMP + (size_t)row * DM + col; *(f32x4*)tp = g0 * acc[ai][bj][m][0]; *(f32x4*)(tp + 4) = g1 * acc[ai][bj][m][1]; }
                        else { const f32x4 v0 = t0[mm][bj] + g0 * acc[ai][bj][m][0], v1 = t1[mm][bj] + g1 * acc[ai][bj][m][1];
                            u32x4 w; w.x = cvt_pk_bf16(v0[0], v0[1]); w.y = cvt_pk_bf16(v0[2], v0[3]); w.z = cvt_pk_bf16(v1[0], v1[1]); w.w = cvt_pk_bf16(v1[2], v1[3]);
                            *(u32x4*)(MERGED + (size_t)row * DM + col) = w; }
                    }
            }
    }
};
struct EpiMergeF {
    static constexpr bool PERM = true; static constexpr int MID_T = 32;
    const bf16_t* GATE; bf16_t* MERGED;
    __device__ __forceinline__ void mid(AccT& acc, const Unit& u, int wr, int wc, int fr, int fq) const {
        const bf16_t* gbase = GATE + (size_t)(u.pm * BM + wr * 64 + fr) * 4096 + u.pn * BM + wc * 32 + 8 * fq;
#define MF_LOAD(i, A, B) do { const bf16_t* gp = gbase + (size_t)((((i) >> 3) * HALF) + (((i) >> 1) & 3) * 16) * 4096 + ((i) & 1) * HALF; A = *(const u32x4*)gp; B = *(const u32x4*)(gp + 2048); } while (0)
#define MF_R(x, y) ((x) * __builtin_amdgcn_rcpf(fmaxf((y), 1e-30f)))
#define MF_APPLY(i, A, B) do { f32x4& c0 = acc[(i) >> 3][(i) & 1][((i) >> 1) & 3][0]; f32x4& c1 = acc[(i) >> 3][(i) & 1][((i) >> 1) & 3][1]; \
        c0[0] *= MF_R(bf_lo(A.x), bf_lo(B.x)); c0[1] *= MF_R(bf_hi(A.x), bf_hi(B.x)); c0[2] *= MF_R(bf_lo(A.y), bf_lo(B.y)); c0[3] *= MF_R(bf_hi(A.y), bf_hi(B.y)); \
        c1[0] *= MF_R(bf_lo(A.z), bf_lo(B.z)); c1[1] *= MF_R(bf_hi(A.z), bf_hi(B.z)); c1[2] *= MF_R(bf_lo(A.w), bf_lo(B.w)); c1[3] *= MF_R(bf_hi(A.w), bf_hi(B.w)); } while (0)
        const bool af = (u.ko == 0);
        u32x4 a0, b0, a1, b1;
        MF_LOAD(0, a0, b0);
#pragma unroll
        for (int i = 0; i < 16; i += 2) {
            MF_LOAD(i + 1, a1, b1); __builtin_amdgcn_sched_barrier(0);
            { const u32x4 n_ = af ? a0 : b0, d_ = af ? b0 : a0; MF_APPLY(i, n_, d_); } __builtin_amdgcn_sched_barrier(0);
            if (i + 2 < 16) MF_LOAD(i + 2, a0, b0);
            __builtin_amdgcn_sched_barrier(0);
            { const u32x4 n_ = af ? a1 : b1, d_ = af ? b1 : a1; MF_APPLY(i + 1, n_, d_); } __builtin_amdgcn_sched_barrier(0);
        }
#undef MF_LOAD
#undef MF_R
#undef MF_APPLY
    }
    __device__ __forceinline__ void operator()(const AccT& acc, const Unit& u, int wr, int wc, int fr, int fq) const {
        const int row0 = u.pm * BM + wr * 64 + fr, col0 = u.pn * BM + wc * 32 + 8 * fq;
#pragma unroll
        for (int ai = 0; ai < 2; ++ai) {
            u32x4 gs[4][2];
#pragma unroll
            for (int m = 0; m < 4; ++m)
#pragma unroll
                for (int bj = 0; bj < 2; ++bj) gs[m][bj] = *(const u32x4*)(GATE + (size_t)(row0 + ai * HALF + m * 16) * 4096 + (u.ko != 0 ? 2048 : 0) + col0 + bj * HALF);
#pragma unroll
            for (int m = 0; m < 4; ++m)
#pragma unroll
                for (int bj = 0; bj < 2; ++bj) {
                    const u32x4 b = gs[m][bj];
                    const f32x4 v0 = acc[ai][bj][m][0] * (f32x4){bf_lo(b.x), bf_hi(b.x), bf_lo(b.y), bf_hi(b.y)}, v1 = acc[ai][bj][m][1] * (f32x4){bf_lo(b.z), bf_hi(b.z), bf_lo(b.w), bf_hi(b.w)};
                    u32x4 w; w.x = cvt_pk_bf16(v0[0], v0[1]); w.y = cvt_pk_bf16(v0[2], v0[3]); w.z = cvt_pk_bf16(v1[0], v1[1]); w.w = cvt_pk_bf16(v1[2], v1[3]);
                    *(u32x4*)(MERGED + (size_t)(row0 + ai * HALF + m * 16) * DM + col0 + bj * HALF) = w;
                }
        }
    }
};
}

namespace att {
constexpr int D = 128, NW = 8, QBLK = 32, KVBLK = 64;
constexpr float SCALE = 0.088388347648318440f, THR = 8.f;
constexpr int LDQ = DM, LDK = 512, LDO = LDAY;
constexpr size_t SHM_V = KVBLK * D * 2, SHM_K = KVBLK * D * 2, SHM_ATTN = 2 * SHM_V + 2 * SHM_K + NW * 64 * 4;
#define KSWZ(row, colB) ((row) * 256 + ((colB) ^ (((row) & 7) << 4)))
#define SBAR() __builtin_amdgcn_sched_barrier(0)
__device__ __forceinline__ int crow(int r, int hi) { return (r & 3) + 8 * (r >> 2) + 4 * hi; }
__device__ __forceinline__ void partialSM(f32x16& p0, f32x16& p1, float& m_reg, float& mn, float& alpha) {
  constexpr float C = SCALE * 1.4426950408889634f;
  float pmax = p0[0]; for (int r = 1; r < 16; ++r) pmax = fmaxf(pmax, p0[r]); for (int r = 0; r < 16; ++r) pmax = fmaxf(pmax, p1[r]);
  { auto rr = __builtin_amdgcn_permlane32_swap(__float_as_uint(pmax), __float_as_uint(pmax), false, false);
    pmax = fmaxf(__uint_as_float(rr[0]), __uint_as_float(rr[1])); }
  if (__builtin_expect(__all(pmax - m_reg <= THR / SCALE), 1)) { mn = m_reg; alpha = 1.f; }
  else { mn = fmaxf(m_reg, pmax); alpha = __builtin_amdgcn_exp2f((m_reg - mn) * C); m_reg = mn; }
  float mnC = -mn * C;
  for (int r = 0; r < 16; ++r) p0[r] = fmaf(p0[r], C, mnC); for (int r = 0; r < 16; ++r) p1[r] = fmaf(p1[r], C, mnC);
  for (int r = 0; r < 16; ++r) p0[r] = __builtin_amdgcn_exp2f(p0[r]);
}
__device__ __forceinline__ void finishSM(f32x16& p0, f32x16& p1, float alpha, float& l_reg, bf16x8& pa0, bf16x8& pa1, bf16x8& pa2, bf16x8& pa3) {
  for (int r = 0; r < 16; ++r) p1[r] = __builtin_amdgcn_exp2f(p1[r]);
  float ps = 0; for (int r = 0; r < 16; ++r) ps += p0[r]; for (int r = 0; r < 16; ++r) ps += p1[r];
  { auto rr = __builtin_amdgcn_permlane32_swap(__float_as_uint(ps), __float_as_uint(ps), false, false);
    ps = __uint_as_float(rr[0]) + __uint_as_float(rr[1]); }
  l_reg = l_reg * alpha + ps;
#define PK4(P, BASE, OUT) do { unsigned a0 = cvt_pk_bf16(P[BASE + 0], P[BASE + 1]), a1 = cvt_pk_bf16(P[BASE + 2], P[BASE + 3]);   \
    unsigned b0 = cvt_pk_bf16(P[BASE + 4], P[BASE + 5]), b1 = cvt_pk_bf16(P[BASE + 6], P[BASE + 7]);                              \
    auto r0 = __builtin_amdgcn_permlane32_swap(a0, b0, false, false); auto r1 = __builtin_amdgcn_permlane32_swap(a1, b1, false, false); \
    u32x4 w = {r0[0], r1[0], r0[1], r1[1]}; OUT = *reinterpret_cast<bf16x8*>(&w); } while (0)
  PK4(p0, 0, pa0); PK4(p0, 8, pa1); PK4(p1, 0, pa2); PK4(p1, 8, pa3);
#undef PK4
}
__device__ __forceinline__ void qkt(f32x16& p0, f32x16& p1, const bf16_t* Ks, const bf16x8* qr, int r32, int hi) {
  p0 = f32x16{}; p1 = f32x16{};
  for (int d0 = 0; d0 < 8; ++d0) { int cb = (d0 * 16 + hi * 8) * 2;
    bf16x8 b0 = *reinterpret_cast<const bf16x8*>((const char*)Ks + KSWZ(r32, cb));
    bf16x8 b1 = *reinterpret_cast<const bf16x8*>((const char*)Ks + KSWZ(32 + r32, cb));
    p0 = __builtin_amdgcn_mfma_f32_32x32x16_bf16(b0, qr[d0], p0, 0, 0, 0);
    p1 = __builtin_amdgcn_mfma_f32_32x32x16_bf16(b1, qr[d0], p1, 0, 0, 0); }
}
__device__ __forceinline__ int v_st(int k, int c) { const int kk = (k & ~0xC) | ((k & 4) << 1) | ((k & 8) >> 1); return ((kk >> 3) * 4 + (c >> 5)) * 512 + ((kk & 7) * 32 + (c & 31)) * 2; }
__device__ __forceinline__ int v_rd_base(int lane) { return ((lane & 3) << 3) | (((lane >> 2) & 3) << 6) | (((lane >> 4) & 1) << 5) | (((lane >> 5) & 1) << 8); }
constexpr int v_rd_off(int d0, int ks, int half) { return d0 * 512 + ks * 4096 + half * 2048; }
template <int OFF> __device__ __forceinline__ s16x4 tr_read(int vb) {
  s16x4 r; asm volatile("ds_read_b64_tr_b16 %0, %1 offset:%2" : "=&v"(r) : "v"(vb), "i"(OFF) : "memory"); return r;
}
template <int D0> __device__ __forceinline__ void pv_one(f32x16& od, int vb, bf16x8 pa0, bf16x8 pa1, bf16x8 pa2, bf16x8 pa3) {
  const s16x4 l0 = tr_read<v_rd_off(D0, 0, 0)>(vb), h0 = tr_read<v_rd_off(D0, 0, 1)>(vb), l1 = tr_read<v_rd_off(D0, 1, 0)>(vb), h1 = tr_read<v_rd_off(D0, 1, 1)>(vb);
  const s16x4 l2 = tr_read<v_rd_off(D0, 2, 0)>(vb), h2 = tr_read<v_rd_off(D0, 2, 1)>(vb), l3 = tr_read<v_rd_off(D0, 3, 0)>(vb), h3 = tr_read<v_rd_off(D0, 3, 1)>(vb);
  asm volatile("s_waitcnt lgkmcnt(0)" ::: "memory"); SBAR();
#define PK(L, H) (bf16x8){L[0], L[1], L[2], L[3], H[0], H[1], H[2], H[3]}
  od = __builtin_amdgcn_mfma_f32_32x32x16_bf16(pa0, PK(l0, h0), od, 0, 0, 0);
  od = __builtin_amdgcn_mfma_f32_32x32x16_bf16(pa1, PK(l1, h1), od, 0, 0, 0);
  od = __builtin_amdgcn_mfma_f32_32x32x16_bf16(pa2, PK(l2, h2), od, 0, 0, 0);
  od = __builtin_amdgcn_mfma_f32_32x32x16_bf16(pa3, PK(l3, h3), od, 0, 0, 0);
#undef PK
}
__device__ __forceinline__ void pv_d0(f32x16* o, int vb, bf16x8 pa0, bf16x8 pa1, bf16x8 pa2, bf16x8 pa3) {
  pv_one<0>(o[0], vb, pa0, pa1, pa2, pa3); pv_one<1>(o[1], vb, pa0, pa1, pa2, pa3); pv_one<2>(o[2], vb, pa0, pa1, pa2, pa3); pv_one<3>(o[3], vb, pa0, pa1, pa2, pa3);
}
__device__ __forceinline__ void attn_dense_body(const bf16_t* Qb, const bf16_t* __restrict__ Kh, const bf16_t* __restrict__ Vh, bf16_t* Ob, int seq, char* lds) {
  const int tid = threadIdx.x, wid = tid >> 6, lane = tid & 63, r32 = lane & 31, hi = lane >> 5;
  bf16_t* V_lds = (bf16_t*)lds; bf16_t* K_lds = (bf16_t*)(lds + 2 * SHM_V);
  float* ws = (float*)(lds + 2 * SHM_V + 2 * SHM_K) + wid * 64; float* li_l = ws; float* al_l = ws + 32;
  float m_reg = -1e30f, l_reg = 0; f32x16 o[4] = {}; bf16x8 qr[8];
  const bf16_t* Qw = Qb + (long)(wid * QBLK + r32) * LDQ + hi * 8;
#pragma unroll
  for (int d0 = 0; d0 < 8; ++d0) qr[d0] = *reinterpret_cast<const bf16x8*>(Qw + d0 * 16);
  const int sr = tid >> 4, sc = (tid & 15) * 8, vst0 = v_st(sr, sc), vst1 = v_st(32 + sr, sc);
  const int vb0 = (int)(uintptr_t)V_lds + v_rd_base(lane);
  struct { bf16x8 vs0, vs1, ks0, ks1; } sr_[2];
#define SLOAD(i, k0) do { sr_[i].vs0 = *reinterpret_cast<const bf16x8*>(&Vh[(long)((k0) + sr) * LDK + sc]); sr_[i].vs1 = *reinterpret_cast<const bf16x8*>(&Vh[(long)((k0) + 32 + sr) * LDK + sc]); \
    sr_[i].ks0 = *reinterpret_cast<const bf16x8*>(&Kh[(long)((k0) + sr) * LDK + sc]); sr_[i].ks1 = *reinterpret_cast<const bf16x8*>(&Kh[(long)((k0) + 32 + sr) * LDK + sc]); } while (0)
#define SWRITE(b, i) do { *(bf16x8*)((char*)V_lds + (b) * SHM_V + vst0) = sr_[i].vs0;          \
    *(bf16x8*)((char*)V_lds + (b) * SHM_V + vst1) = sr_[i].vs1; int kc = sc * 2;               \
    *(bf16x8*)((char*)K_lds + (b) * SHM_K + KSWZ(sr, kc)) = sr_[i].ks0;                       \
    *(bf16x8*)((char*)K_lds + (b) * SHM_K + KSWZ(32 + sr, kc)) = sr_[i].ks1; } while (0)
#define SWAIT() asm volatile("s_waitcnt vmcnt(4)" ::: "memory")
#define RESC(a) do { if (__any((a) < 1.f)) { if (hi == 0) al_l[r32] = (a); asm volatile("s_waitcnt lgkmcnt(0)" ::: "memory"); \
    for (int d = 0; d < 4; ++d) for (int r = 0; r < 16; ++r) o[d][r] *= al_l[crow(r, hi)]; } } while (0)
  f32x16 pA0, pA1, pB0, pB1; float mnA, mnB, alA, alB; bf16x8 pa0, pa1, pa2, pa3; const int NT = seq / KVBLK;
  constexpr int SE = 0, SO = 1;
  SLOAD(SE, 0); asm volatile("s_waitcnt vmcnt(0)" ::: "memory"); SWRITE(0, SE); __syncthreads();
  qkt(pA0, pA1, K_lds, qr, r32, hi); partialSM(pA0, pA1, m_reg, mnA, alA);
  SLOAD(SO, KVBLK); if (2 < NT) SLOAD(SE, 2 * KVBLK);
  SWAIT(); SWRITE(1, SO); __syncthreads();
  for (int j = 1; j + 1 < NT; j += 2) {
    SBAR(); qkt(pB0, pB1, (bf16_t*)((char*)K_lds + SHM_K), qr, r32, hi);
    finishSM(pA0, pA1, alA, l_reg, pa0, pa1, pa2, pa3); SBAR();
    SLOAD(SO, (j + 2) * KVBLK); SBAR();
    pv_d0(o, vb0, pa0, pa1, pa2, pa3); partialSM(pB0, pB1, m_reg, mnB, alB);
    __syncthreads(); SWAIT(); SWRITE(0, SE);
    RESC(alB); __syncthreads();
    SBAR(); qkt(pA0, pA1, K_lds, qr, r32, hi);
    finishSM(pB0, pB1, alB, l_reg, pa0, pa1, pa2, pa3); SBAR();
    if (j + 3 < NT) SLOAD(SE, (j + 3) * KVBLK); SBAR();
    pv_d0(o, vb0 + (int)SHM_V, pa0, pa1, pa2, pa3); partialSM(pA0, pA1, m_reg, mnA, alA);
    __syncthreads(); SWAIT(); SWRITE(1, SO);
    RESC(alA); __syncthreads();
  }
  SBAR(); qkt(pB0, pB1, (bf16_t*)((char*)K_lds + SHM_K), qr, r32, hi);
  finishSM(pA0, pA1, alA, l_reg, pa0, pa1, pa2, pa3); SBAR();
  pv_d0(o, vb0, pa0, pa1, pa2, pa3); partialSM(pB0, pB1, m_reg, mnB, alB);
  __syncthreads(); RESC(alB);
  finishSM(pB0, pB1, alB, l_reg, pa0, pa1, pa2, pa3); SBAR();
  pv_d0(o, vb0 + (int)SHM_V, pa0, pa1, pa2, pa3);
  if (hi == 0) li_l[r32] = l_reg; asm volatile("s_waitcnt lgkmcnt(0)" ::: "memory");
  float rli[16];
#pragma unroll
  for (int r = 0; r < 16; ++r) rli[r] = __builtin_amdgcn_rcpf(li_l[crow(r, hi)]);
  bf16_t* Ow = Ob + (long)(wid * QBLK) * LDO;
#pragma unroll
  for (int r = 0; r < 16; ++r) { int orow = crow(r, hi);
    for (int d0 = 0; d0 < 4; ++d0) Ow[(long)orow * LDO + d0 * 32 + r32] = (bf16_t)(cvt_pk_bf16(o[d0][r] * rli[r], 0.f) & 0xffffu); }
  __syncthreads();
#undef SLOAD
#undef SWRITE
#undef SWAIT
#undef RESC
}
}

struct Args { const float* in[29]; float* out; unsigned char* ws; int ph_lo, ph_hi; };

__device__ __forceinline__ void mod_phase(const Args& a, float* MOD, LAS unsigned char* lds, int tid) {
    LAS float* sc = (LAS float*)lds;
    LAS float* red = sc + 5 * DM;
    const float* c = a.in[1]; const float* cc = a.in[3]; const float* wm = a.in[4]; const float* bm = a.in[5];
    for (int i = tid; i < 5 * DM; i += 512) { const float v = i < 4 * DM ? c[i] : cc[i - 4 * DM]; sc[i] = silu_f(v); }
    __syncthreads();
    for (int cb = blockIdx.x; cb < NMOD / 72; cb += gridDim.x) {
        const int cg_ = tid % 18, kg = tid / 18;
        if (kg < 28) {
            f32x4 acc[5];
#pragma unroll
            for (int r = 0; r < 5; ++r) acc[r] = (f32x4){0.f, 0.f, 0.f, 0.f};
            const float* wp = wm + (size_t)cb * 72 + cg_ * 4;
#pragma unroll 8
            for (int k = kg; k < DM; k += 28) {
                const f32x4 w = __builtin_nontemporal_load((const f32x4*)(wp + (size_t)k * NMOD));
#pragma unroll
                for (int r = 0; r < 5; ++r) acc[r] += w * sc[r * DM + k];
            }
#pragma unroll
            for (int r = 0; r < 5; ++r)
#pragma unroll
                for (int j = 0; j < 4; ++j) red[(kg * 5 + r) * 72 + cg_ * 4 + j] = acc[r][j];
        }
        __syncthreads();
        if (tid < 360) { const int r = tid / 72, col = tid % 72; float s = bm[cb * 72 + col];
            for (int kg2 = 0; kg2 < 28; ++kg2) s += red[(kg2 * 5 + r) * 72 + col];
            MOD[(size_t)r * NMOD + cb * 72 + col] = s; }
        __syncthreads();
    }
}

struct CvtItem { const float* wp; bf16_t* dp; int N, K; };
__device__ __forceinline__ CvtItem cvt_decode(const Args& a, unsigned char* ws, int it, int lane) {
    constexpr int I_GU = (DM / 64) * (DFF / 32), I_DN = (DFF / 64) * (DM / 32), I_IN = (DM / 64) * (INW / 32), I_GLU = (SSMW / 64) * (SSMW / 32),
                  I_BRA = (DM / 64) * (DM / 32), I_BRS = (SSMW / 64) * (DM / 32), I_OUT = I_BRA;
    int r = it; const float* W; int K, N, mode = 0, ldw = 0; bf16_t* WT;
    if (r < I_GU) { W = a.in[7]; K = DM; N = DFF; WT = (bf16_t*)(ws + WS_W1GU); mode = 1; }
    else if ((r -= I_GU) < I_GU) { W = a.in[8]; K = DM; N = DFF; WT = (bf16_t*)(ws + WS_W1GU); mode = 2; }
    else if ((r -= I_GU) < I_DN) { W = a.in[9]; K = DFF; N = DM; WT = (bf16_t*)(ws + WS_W1D); }
    else if ((r -= I_DN) < I_IN) { W = a.in[10]; K = DM; N = INW; WT = (bf16_t*)(ws + WS_WIN); }
    else if ((r -= I_IN) < I_GLU) { W = a.in[21]; K = SSMW; N = SSMW; WT = (bf16_t*)(ws + WS_WGLU); }
    else if ((r -= I_GLU) < I_BRA) { W = a.in[23]; K = DM; N = DM; WT = (bf16_t*)(ws + WS_WBRA); ldw = LDAY; }
    else if ((r -= I_BRA) < I_BRS) { W = a.in[24]; K = SSMW; N = DM; WT = (bf16_t*)(ws + WS_WBRA) + 2048; ldw = LDAY; }
    else if ((r -= I_BRS) < I_OUT) { W = a.in[25]; K = DM; N = DM; WT = (bf16_t*)(ws + WS_WOUT); }
    else if ((r -= I_OUT) < I_GU) { W = a.in[26]; K = DM; N = DFF; WT = (bf16_t*)(ws + WS_W2GU); mode = 1; }
    else if ((r -= I_GU) < I_GU) { W = a.in[27]; K = DM; N = DFF; WT = (bf16_t*)(ws + WS_W2GU); mode = 2; }
    else { r -= I_GU; W = a.in[28]; K = DFF; N = DM; WT = (bf16_t*)(ws + WS_W2D); }
    const int nblk = N / 32, kb = r / nblk, nb = r % nblk, n0 = nb * 32, k0 = kb * 64;
    const int drow0 = mode == 0 ? n0 : ((n0 >> 7) * 256 + (mode == 2 ? 128 : 0) + (n0 & 127));
    CvtItem c; c.wp = W + (size_t)(k0 + (lane >> 5)) * N + n0 + (lane & 31); if (ldw == 0) ldw = K; c.dp = WT + (size_t)drow0 * ldw + k0; c.N = N; c.K = ldw; return c;
}
__device__ __forceinline__ void cvt_load(float (&v)[32], const CvtItem& c) {
#pragma unroll
    for (int i = 0; i < 32; ++i) v[i] = __builtin_nontemporal_load(c.wp + (size_t)(2 * i) * c.N);
}
__device__ __forceinline__ void cvt_store(const float (&v)[32], const CvtItem& c, LAS float* scr, int lane) {
#pragma unroll
    for (int i = 0; i < 32; ++i) scr[(2 * i + (lane >> 5)) * 33 + (lane & 31)] = v[i];
    LDS_WAIT();
    const int cc = lane & 7;
#pragma unroll
    for (int j = 0; j < 4; ++j) { const int n = (lane >> 3) + 8 * j; const LAS float* s = scr + (8 * cc) * 33 + n;
        u32x4 o; o.x = cvt_pk_bf16(s[0 * 33], s[1 * 33]); o.y = cvt_pk_bf16(s[2 * 33], s[3 * 33]); o.z = cvt_pk_bf16(s[4 * 33], s[5 * 33]); o.w = cvt_pk_bf16(s[6 * 33], s[7 * 33]);
        *(u32x4*)(c.dp + (size_t)n * c.K + 8 * cc) = o; }
    LDS_WAIT();
}
__device__ __forceinline__ void weights_phase(const Args& a, unsigned char* ws, LAS unsigned char* lds, int wave, int lane) {
    LAS float* scr = (LAS float*)(lds + wave * 8704);
    const int gw = blockIdx.x * 8 + wave, NGW = gridDim.x * 8;
    constexpr int NITEMS = 47616;
    float va[32], vb[32]; CvtItem ca, cb;
    int it = gw;
    if (it < NITEMS) { ca = cvt_decode(a, ws, it, lane); cvt_load(va, ca); }
    while (it < NITEMS) {
        const int it2 = it + NGW, it3 = it2 + NGW;
        if (it2 < NITEMS) { cb = cvt_decode(a, ws, it2, lane); cvt_load(vb, cb); }
        cvt_store(va, ca, scr, lane);
        if (it3 < NITEMS) { ca = cvt_decode(a, ws, it3, lane); cvt_load(va, ca); }
        if (it2 < NITEMS) cvt_store(vb, cb, scr, lane);
        it = it3;
    }
    __syncthreads();
}

__device__ __forceinline__ void ssm_params_phase(const Args& a, unsigned char* ws, LAS unsigned char* lds, int tid, int wi0, int wi_end, int wi_step) {
    LAS f32x2* lbp = (LAS f32x2*)lds;
    LAS f32x2* Bb = lbp + 2 * 17 * 64;
    LAS f32x2* Cc = Bb + 2 * 64 * 16;
    LAS float* KF = (LAS float*)(Cc + 2 * 16 * 64);
    LAS f32x2* cf = (LAS f32x2*)(KF + 2 * 16 * 256);
    const float *a_re = a.in[13], *a_im = a.in[14], *log_dt = a.in[15], *b_re = a.in[16], *b_im = a.in[17], *c_re = a.in[18], *c_im = a.in[19], *dvec = a.in[20];
    bf16_t* WY = (bf16_t*)(ws + WS_WY); bf16_t* WST = (bf16_t*)(ws + WS_WST);
    for (int wi = wi0; wi < wi_end; wi += wi_step) {
        const int g = wi >> 2, q = wi & 3;
        if (tid < 128) {
            const int dir = tid >> 6, p = tid & 63;
            const float dt = expf(log_dt[dir * 64 + g]), ar = a_re[(dir * 64 + g) * 64 + p], ai = a_im[(dir * 64 + g) * 64 + p];
            const float x = ar * dt, y = ai * dt, mag = expf(x), cy = cosf(y), sy = sinf(y), sh = sinf(0.5f * y);
            const f32x2 lb = (f32x2){mag * cy, mag * sy};
            const float lm1r = expm1f(x) * cy - 2.f * sh * sh, lm1i = lb.y, den = ar * ar + ai * ai;
            cf[tid] = (f32x2){(lm1r * ar + lm1i * ai) / den, (lm1i * ar - lm1r * ai) / den};
            f32x2 w = (f32x2){1.f, 0.f};
            for (int e = 0; e <= 16; ++e) { lbp[(dir * 17 + e) * 64 + p] = w; w = cmul(w, lb); }
        }
        __syncthreads();
#pragma unroll
        for (int i = 0; i < 4; ++i) {
            const int idx = tid + 512 * i, dir = idx >> 10;
            { const int p = (idx >> 4) & 63, c = idx & 15, src = ((dir * 64 + g) * 64 + p) * 16 + c; Bb[idx] = cmul(cf[dir * 64 + p], (f32x2){b_re[src], b_im[src]}); }
            { const int co = (idx >> 6) & 15, p = idx & 63, src = ((dir * 64 + g) * 16 + co) * 64 + p; Cc[idx] = (f32x2){c_re[src], c_im[src]}; }
        }
        __syncthreads();
        {
            const int dir = tid >> 8, co = (tid >> 4) & 15, ci = tid & 15;
            float acc[16];
#pragma unroll
            for (int j = 0; j < 16; ++j) acc[j] = 0.f;
            for (int p = 0; p < 64; ++p) {
                f32x2 w = cmul(Cc[(dir * 16 + co) * 64 + p], Bb[(dir * 64 + p) * 16 + ci]); const f32x2 lb = lbp[(dir * 17 + 1) * 64 + p];
#pragma unroll
                for (int j = 0; j < 16; ++j) { acc[j] += w.x; w = cmul(w, lb); }
            }
#pragma unroll
            for (int j = 0; j < 16; ++j) KF[(dir * 16 + j) * 256 + co * 16 + ci] = acc[j];
        }
        __syncthreads();
#pragma unroll 1
        for (int i = 0; i < 8; ++i) {
            const int v = tid + 512 * i, n = 64 * q + (v >> 6), k0 = (v & 63) * 8, t = n >> 4, co = n & 15;
            float vals[8];
            if (k0 < 256) { const int s = k0 >> 4, ci0 = k0 & 15;
#pragma unroll
                for (int e = 0; e < 8; ++e) { const int idx = co * 16 + ci0 + e; float val;
                    if (s < t) val = KF[(t - s) * 256 + idx]; else if (s > t) val = KF[(16 + s - t) * 256 + idx];
                    else val = KF[idx] + KF[16 * 256 + idx] + ((co == ci0 + e) ? dvec[g * 16 + co] : 0.f);
                    vals[e] = val; }
            } else { const int kk = k0 - 256, dir = kk >> 7, p0 = (kk & 127) >> 1, ex = dir == 0 ? t + 1 : 16 - t;
#pragma unroll
                for (int pp = 0; pp < 4; ++pp) { const f32x2 cl = cmul(Cc[(dir * 16 + co) * 64 + p0 + pp], lbp[(dir * 17 + ex) * 64 + p0 + pp]); vals[2 * pp] = cl.x; vals[2 * pp + 1] = -cl.y; }
            }
            u32x4 w; w.x = cvt_pk_bf16(vals[0], vals[1]); w.y = cvt_pk_bf16(vals[2], vals[3]); w.z = cvt_pk_bf16(vals[4], vals[5]); w.w = cvt_pk_bf16(vals[6], vals[7]);
            *(u32x4*)(WY + ((size_t)(g * 256 + n) * 512 + k0)) = w;
        }
#pragma unroll 1
        for (int i = 0; i < 4; ++i) {
            const int v = tid + 512 * i, n = 64 * q + (v >> 5), k0 = (v & 31) * 8, dir = n >> 7, p = (n & 127) >> 1, ri = n & 1, t = k0 >> 4, c0 = k0 & 15;
            const f32x2 l = lbp[(dir * 17 + (dir == 0 ? 15 - t : t)) * 64 + p];
            float vals[8];
#pragma unroll
            for (int e = 0; e < 8; ++e) { const f32x2 z = cmul(l, Bb[(dir * 64 + p) * 16 + c0 + e]); vals[e] = ri ? z.y : z.x; }
            u32x4 w; w.x = cvt_pk_bf16(vals[0], vals[1]); w.y = cvt_pk_bf16(vals[2], vals[3]); w.z = cvt_pk_bf16(vals[4], vals[5]); w.w = cvt_pk_bf16(vals[6], vals[7]);
            *(u32x4*)(WST + ((size_t)(g * 256 + n) * 256 + k0)) = w;
        }
        __syncthreads();
    }
}

template <bool SLABS, bool DELTA>
__device__ __forceinline__ void norm_phase(const float* xlat, const float* xctx, const float* gam, const float* MOD, int sh_off, int sc_off, bf16_t* H, int nrows, int wave, int lane, const float* slabs = nullptr, const bf16_t* delta = nullptr) {
    const int gw = blockIdx.x * 8 + wave, NGW = gridDim.x * 8;
    for (int m = gw; m < nrows; m += NGW) {
        const float* xr = (m < ML ? xlat + (size_t)m * DM : xctx + (size_t)(m - ML) * DM) + lane * 4;
        const float* mr = MOD + (size_t)(m < ML ? (m >> 11) : 4) * NMOD + lane * 4;
        f32x4 v[8]; float ss = 0.f;
#pragma unroll
        for (int j = 0; j < 8; ++j) { v[j] = *(const f32x4*)(xr + 256 * j);
            if (DELTA && m < ML) { const u32x2 dd = *(const u32x2*)(delta + (size_t)m * DM + lane * 4 + 256 * j); v[j] += (f32x4){bf_lo(dd.x), bf_hi(dd.x), bf_lo(dd.y), bf_hi(dd.y)}; }
            if (SLABS && m >= ML) { const float* sp = slabs + (size_t)(m - ML) * DM + lane * 4 + 256 * j;
                const f32x4 p = (*(const f32x4*)sp + *(const f32x4*)(sp + (size_t)MC * DM)) + (*(const f32x4*)(sp + (size_t)2 * MC * DM) + *(const f32x4*)(sp + (size_t)3 * MC * DM));
                v[j] += (*(const f32x4*)(mr + 2 * DM + 256 * j) * 0.5f) * p; }
            ss += (v[j].x * v[j].x + v[j].y * v[j].y) + (v[j].z * v[j].z + v[j].w * v[j].w); }
        const float rstd = rsqrtf(wave_sum(ss) * (1.f / DM) + EPS);
#pragma unroll
        for (int j = 0; j < 8; ++j) {
            const f32x4 gg = *(const f32x4*)(gam + lane * 4 + 256 * j), sh = *(const f32x4*)(mr + sh_off + 256 * j), sc = *(const f32x4*)(mr + sc_off + 256 * j);
            const f32x4 h = (v[j] * rstd) * gg * (sc + 1.f) + sh;
            u32x2 w; w.x = cvt_pk_bf16(h.x, h.y); w.y = cvt_pk_bf16(h.z, h.w);
            *(u32x2*)(H + (size_t)m * DM + lane * 4 + 256 * j) = w;
        }
    }
}

__device__ __forceinline__ void qknorm_phase(bf16_t* Q, bf16_t* Kb, const float* q_g, const float* k_g, int wave, int lane) {
    const int gw = blockIdx.x * 8 + wave, NGW = gridDim.x * 8;
    constexpr int NQ = ML * 16, NK = NB * SKV * 4, NIT = (NQ + NK) / 4;
    const int j = lane & 15, part = j >> 3, i0 = 4 * (j & 7), e0 = part * 64 + i0;
    for (int it = gw; it < NIT; it += NGW) {
        const int hr = it * 4 + (lane >> 4);
        bf16_t* base; int t; bool rope; const float* gn;
        if (hr < NQ) { const int row = hr >> 4; base = Q + (size_t)row * DM + (hr & 15) * 128; t = row & 2047; rope = true; gn = q_g; }
        else { const int r = hr - NQ, tok = r >> 2, pos = tok % SKV; base = Kb + (size_t)tok * 512 + (r & 3) * 128; rope = pos >= LC; t = pos - LC; gn = k_g; }
        const u32x2 wa = *(const u32x2*)(base + e0), wb = *(const u32x2*)(base + e0 + 32);
        float x1[4] = {bf_lo(wa.x), bf_hi(wa.x), bf_lo(wa.y), bf_hi(wa.y)}, x2[4] = {bf_lo(wb.x), bf_hi(wb.x), bf_lo(wb.y), bf_hi(wb.y)};
        float ss = 0.f;
#pragma unroll
        for (int e = 0; e < 4; ++e) ss += x1[e] * x1[e] + x2[e] * x2[e];
        ss += __shfl_xor(ss, 1); ss += __shfl_xor(ss, 2); ss += __shfl_xor(ss, 4); ss += __shfl_xor(ss, 8);
        const float rstd = rsqrtf(ss * (1.f / 128.f) + EPS);
        const float pidx = (float)(part == 0 ? (t >> 6) : (t & 63));
#pragma unroll
        for (int e = 0; e < 4; ++e) {
            float a1 = x1[e] * rstd * gn[e0 + e], a2 = x2[e] * rstd * gn[e0 + 32 + e];
            if (rope) { const float f = __builtin_amdgcn_exp2f(-(float)(i0 + e) * (13.287712379549449f / 32.f)), rev = pidx * f * 0.15915494309189535f, cs = __builtin_amdgcn_cosf(rev), sn = __builtin_amdgcn_sinf(rev);
                const float o1 = a1 * cs - a2 * sn, o2 = a2 * cs + a1 * sn; a1 = o1; a2 = o2; }
            x1[e] = a1; x2[e] = a2;
        }
        u32x2 oa, ob; oa.x = cvt_pk_bf16(x1[0], x1[1]); oa.y = cvt_pk_bf16(x1[2], x1[3]); ob.x = cvt_pk_bf16(x2[0], x2[1]); ob.y = cvt_pk_bf16(x2[2], x2[3]);
        *(u32x2*)(base + e0) = oa; *(u32x2*)(base + e0 + 32) = ob;
    }
}

__device__ __forceinline__ void scan_phase(const Args& a, const float* S, bf16_t* A2, int tid) {
    const float *a_re = a.in[13], *a_im = a.in[14], *log_dt = a.in[15];
    for (int ch = blockIdx.x * 512 + tid; ch < NB * 64 * 2 * 64; ch += gridDim.x * 512) {
        const int p = ch & 63, dir = (ch >> 6) & 1, g = (ch >> 7) & 63, b = ch >> 13;
        const float dt = expf(log_dt[dir * 64 + g]), ar = a_re[(dir * 64 + g) * 64 + p], ai = a_im[(dir * 64 + g) * 64 + p];
        const float x = ar * dt, y = ai * dt, mag = expf(x);
        f32x2 lb = (f32x2){mag * cosf(y), mag * sinf(y)};
        lb = cmul(lb, lb); lb = cmul(lb, lb); lb = cmul(lb, lb); lb = cmul(lb, lb);
        const float* Sp = S + ((size_t)(g * SROWS + b * NCH) * 256 + dir * 128 + 2 * p);
        bf16_t* Ap = A2 + ((size_t)(g * SROWS_PAD + b * NCH) * 512 + 256 + dir * 128 + 2 * p);
        f32x2 h = (f32x2){0.f, 0.f};
#pragma unroll 8
        for (int i = 0; i < NCH; ++i) {
            const int c = dir == 0 ? i : (i < 16 ? 15 - i : 159 - i);
            const f32x2 s = *(const f32x2*)(Sp + (size_t)c * 256);
            *(unsigned*)(Ap + (size_t)c * 512) = cvt_pk_bf16(h.x, h.y);
            h = cmul(lb, h) + s;
        }
    }
}


#define XB_TMO      128
#define XB_XCNT(j)  (256  + 64 * (j))
#define XB_XSUB(j)  (1280 + 64 * (j))
#define XB_XGEN(j)  (2304 + 64 * (j))
#define XB_TOP      3328
#define XB_TOPGEN   3392
#define XCD_BAR_WORDS 3456
#define XB_SPIN_CAP (1u << 18)
__device__ __forceinline__ unsigned xb_ld(unsigned* p)              { return __hip_atomic_load(p, __ATOMIC_RELAXED, __HIP_MEMORY_SCOPE_AGENT); }
__device__ __forceinline__ unsigned xb_add(unsigned* p, unsigned v) { return __hip_atomic_fetch_add(p, v, __ATOMIC_RELAXED, __HIP_MEMORY_SCOPE_AGENT); }
__device__ __forceinline__ unsigned xb_xcc_id() { return (unsigned)__builtin_amdgcn_s_getreg((3 << 11) | 20) & 0xFu; }
#define XB_SPIN(cond, bar) do { unsigned _sp = 0; while (cond) { __builtin_amdgcn_s_sleep(1); \
    if ((++_sp & 255u) == 0u) { if (xb_ld(&(bar)[XB_TMO])) break; if (_sp > XB_SPIN_CAP) { atomicAdd(&(bar)[XB_TMO], 1u); break; } } } } while (0)
struct XcdBarrier { unsigned* bar; unsigned x; volatile LAS unsigned* st; };
__device__ __forceinline__ XcdBarrier xcd_barrier_post(unsigned* bar, volatile LAS unsigned* st) {
    XcdBarrier b; b.bar = bar; b.x = xb_xcc_id(); b.st = st;
    if (threadIdx.x == 0) (void)xb_add(&bar[XB_XCNT(b.x)], 1u);
    return b;
}
__device__ __forceinline__ void xcd_barrier_complete(unsigned* bar, unsigned x, unsigned& nloc, unsigned& nx) {
    const unsigned G = gridDim.x * gridDim.y * gridDim.z;
    unsigned sum, cnt, mine, sp = 0u;
    for (;;) {
        sum = 0u; cnt = 0u; mine = 0u;
#pragma unroll
        for (unsigned j = 0; j < 16; ++j) { const unsigned c = xb_ld(&bar[XB_XCNT(j)]); sum += c; cnt += (c > 0u) ? 1u : 0u; mine = (j == x) ? c : mine; }
        if (sum == G) break;
        __builtin_amdgcn_s_sleep(1);
        if ((++sp & 255u) == 0u) { if (xb_ld(&bar[XB_TMO])) break; if (sp > XB_SPIN_CAP) { atomicAdd(&bar[XB_TMO], 1u); break; } }
    }
    nloc = mine > 0u ? mine : 1u; nx = cnt > 0u ? cnt : 1u;
}
__device__ __forceinline__ void xcd_barrier(const XcdBarrier& b) {
    asm volatile("s_waitcnt vmcnt(0)" ::: "memory");
    __syncthreads();
    if (threadIdx.x == 0) {
        unsigned* bar = b.bar;
        __builtin_amdgcn_s_waitcnt(0);
        unsigned nloc = b.st[0], nx = b.st[1];
        if (nloc == 0u) { xcd_barrier_complete(bar, b.x, nloc, nx); b.st[0] = nloc; b.st[1] = nx; }
        const unsigned old = xb_add(&bar[XB_XSUB(b.x)], 1u);
        const unsigned gen = old / nloc;
        if (old + 1u == (gen + 1u) * nloc) {
            __builtin_amdgcn_fence(__ATOMIC_RELEASE, "agent");
            asm volatile("s_waitcnt vmcnt(0)" ::: "memory");
            const unsigned og = xb_add(&bar[XB_TOP], 1u);
            const unsigned tg = og / nx;
            if (og + 1u == (tg + 1u) * nx) xb_add(&bar[XB_TOPGEN], 1u);
            else XB_SPIN(xb_ld(&bar[XB_TOPGEN]) == tg, bar);
            __builtin_amdgcn_fence(__ATOMIC_ACQUIRE, "agent");
            xb_add(&bar[XB_XGEN(b.x)], 1u);
            asm volatile("s_waitcnt vmcnt(0)" ::: "memory");
        } else {
            XB_SPIN(xb_ld(&bar[XB_XGEN(b.x)]) == gen, bar);
            __builtin_amdgcn_fence(__ATOMIC_ACQUIRE, "agent");
            asm volatile("s_waitcnt vmcnt(0)" ::: "memory");
        }
    }
    __syncthreads();
}

#ifndef REP_0
#define REP_0 1
#endif
#ifndef REP_1
#define REP_1 1
#endif
#ifndef REP_2
#define REP_2 1
#endif
#ifndef REP_3
#define REP_3 1
#endif
#ifndef REP_4
#define REP_4 1
#endif
#ifndef REP_5
#define REP_5 1
#endif
#ifndef REP_6
#define REP_6 1
#endif
#ifndef REP_7
#define REP_7 1
#endif
#ifndef REP_8
#define REP_8 1
#endif
#ifndef REP_9
#define REP_9 1
#endif
#ifndef REP_10
#define REP_10 1
#endif
#ifndef REP_11
#define REP_11 1
#endif
#ifndef REP_12
#define REP_12 1
#endif
#ifndef REP_13
#define REP_13 1
#endif
#ifndef REP_14
#define REP_14 1
#endif
#ifndef ATT_REP
#define ATT_REP 1
#endif
#ifndef UREP_3
#define UREP_3 1
#endif
#ifndef UREP_11
#define UREP_11 1
#endif
#ifndef UREP_13
#define UREP_13 1
#endif
constexpr int NPH = 15;
template <bool COOP>
__global__ void __launch_bounds__(512) mega(Args a) {
    __builtin_assume(__builtin_amdgcn_workitem_id_y() == 0); __builtin_assume(__builtin_amdgcn_workitem_id_z() == 0);
    extern __shared__ __attribute__((aligned(16))) unsigned char lds_raw[];
    LAS unsigned char* lds = (LAS unsigned char*)lds_raw;
    const int tid = threadIdx.x, lane = tid & 63, wave = __builtin_amdgcn_readfirstlane(tid >> 6);
    const int G = gridDim.x, bx = blockIdx.x;
    unsigned char* ws = a.ws;
    float* MOD = (float*)(ws + WS_MOD);
    bf16_t* H = (bf16_t*)(ws + WS_H); bf16_t* ACT = (bf16_t*)(ws + WS_ACT); bf16_t* D1 = (bf16_t*)(ws + WS_X1); bf16_t* D2 = D1 + (size_t)ML * DM;
    bf16_t* Qb = (bf16_t*)(ws + WS_Q); bf16_t* Kb = (bf16_t*)(ws + WS_K); bf16_t* Vb = (bf16_t*)(ws + WS_V);
    bf16_t* A2 = (bf16_t*)(ws + WS_A2); float* Sst = (float*)(ws + WS_S);
    bf16_t* GATE = (bf16_t*)(ws + WS_GATE); bf16_t* YG = (bf16_t*)(ws + WS_YG); bf16_t* Y2 = (bf16_t*)(ws + WS_AY); bf16_t* MERGED = (bf16_t*)(ws + WS_MERGED);
    const int lo = a.ph_lo, hi = a.ph_hi;
#define IN(k) (lo <= (k) && (k) < hi)
#define SEAM(k) do { if (COOP && IN(k) && IN((k) + 1)) { if ((k) == 0) cg::this_grid().sync(); else xcd_barrier(xbar); } } while (0)
    XcdBarrier xbar; xbar.bar = (unsigned*)(ws + WS_BAR); xbar.x = 0; xbar.st = nullptr;
    if (COOP) { volatile LAS unsigned* st = (volatile LAS unsigned*)(lds + LDS_XB_OFF); if (tid < 4) st[tid] = 0u; __syncthreads(); xbar = xcd_barrier_post((unsigned*)(ws + WS_BAR), st); }

    if (IN(0)) for (int rep_ = 0; rep_ < REP_0; ++rep_) { mod_phase(a, MOD, lds, tid); if (G != 256) ssm_params_phase(a, ws, lds, tid, bx, 256, G); weights_phase(a, ws, lds, wave, lane); }
    SEAM(0);
    if (IN(1)) for (int rep_ = 0; rep_ < REP_1; ++rep_) norm_phase<false, false>(a.in[0], a.in[2], a.in[6], MOD, 0, DM, H, MT, wave, lane);
    SEAM(1);
    if (IN(2)) for (int rep_ = 0; rep_ < REP_2; ++rep_) { pg8::Gemm g{H, (const bf16_t*)(ws + WS_W1GU), DM, DM, DM}; pg8::RectOrder S; S.init(MT / 256, 2 * DFF / 256, G, bx);
        pg8::EpiSwiGLU E{ACT}; pg8::gemm_phase(lds, g, S, E);
        if (G == 256 && bx >= 48 && bx < 176) ssm_params_phase(a, ws, lds, tid, bx - 48, bx - 47, 1); }
    SEAM(2);
    if (IN(3)) for (int rep_ = 0; rep_ < REP_3; ++rep_) {
        { pg8::Gemm g{ACT + (size_t)ML * DFF, (const bf16_t*)(ws + WS_W1D), DFF, DFF, 1408}; pg8::CtxSplitOrder S{G, bx};
          pg8::EpiPartial E{Sst}; pg8::gemm_phase(lds, g, S, E); }
        { pg8::Gemm g{ACT, (const bf16_t*)(ws + WS_W1D), DFF, DFF, DFF}; pg8::RectOrder S; S.init(ML / 256, DM / 256, G, bx); S.rep = UREP_3;
          pg8::EpiDelta<false> E{nullptr, D1, MOD, 2 * DM, 0.5f}; pg8::gemm_phase(lds, g, S, E); } }
    SEAM(3);
    if (IN(4)) for (int rep_ = 0; rep_ < REP_4; ++rep_) norm_phase<true, true>(a.in[0], a.in[2], a.in[6] + DM, MOD, 3 * DM, 4 * DM, H, MT, wave, lane, Sst, D1);
    SEAM(4);
    if (IN(5)) for (int rep_ = 0; rep_ < REP_5; ++rep_) { pg8::Gemm g{H, (const bf16_t*)(ws + WS_WIN), DM, DM, DM}; pg8::InProjOrder S; S.r0.init(ML / 256, INW / 256, G, bx); S.G = G; S.c = bx;
        pg8::EpiInProj E{Kb, Vb, A2, Qb, GATE}; pg8::gemm_phase(lds, g, S, E);
        if (G == 256 && bx >= 32 && bx < 160) ssm_params_phase(a, ws, lds, tid, 128 + bx - 32, 129 + bx - 32, 1); }
    SEAM(5);
    if (IN(6)) for (int rep_ = 0; rep_ < REP_6; ++rep_) { qknorm_phase(Qb, Kb, a.in[11], a.in[12], wave, lane);
        pg8::Gemm g{A2, (const bf16_t*)(ws + WS_WST), 512, 256, 256}; pg8::BatchOrder S{G, bx}; pg8::EpiState E{Sst}; pg8::gemm_phase(lds, g, S, E); }
    SEAM(6);
    if (IN(7)) for (int rep_ = 0; rep_ < REP_7; ++rep_) scan_phase(a, Sst, A2, tid);
    SEAM(7);
    if (IN(8)) for (int rep_ = 0; rep_ < REP_8; ++rep_) { { pg8::Gemm g{A2, (const bf16_t*)(ws + WS_WY), 512, 512, 512}; pg8::BatchOrder S{G, bx}; pg8::EpiSsmOut E{YG}; pg8::gemm_phase(lds, g, S, E); }
        for (int it_ = bx; it_ < ATT_REP * NB * 16 * (SEQ / 256); it_ += G) {
            const int it = it_ & 511, qb = it & 7, h = (it >> 3) & 15, b = it >> 7;
            bf16_t* q = Qb + ((size_t)(b * SEQ + qb * 256) * DM + h * 128);
            const size_t k0 = (size_t)b * SKV * 512 + (h >> 2) * 128;
            att::attn_dense_body(q, Kb + k0, Vb + k0, (bf16_t*)(ws + WS_AY) + ((size_t)(b * SEQ + qb * 256) * LDAY + h * 128), SKV, (char*)lds_raw);
        } }
    SEAM(8);
    if (IN(9)) for (int rep_ = 0; rep_ < REP_9; ++rep_) { pg8::Gemm g{YG, (const bf16_t*)(ws + WS_WGLU), SSMW, SSMW, SSMW}; pg8::RectOrder S; S.init(ML / 256, SSMW / 256, G, bx);
        pg8::EpiGlu E{YG, a.in[22], Y2}; pg8::gemm_phase(lds, g, S, E); }
    SEAM(9);
    if (IN(10)) for (int rep_ = 0; rep_ < REP_10; ++rep_) { pg8::MergeOrder S; S.r.init(ML / 256, DM / 256, G, bx);
        { pg8::Gemm g{(const bf16_t*)(ws + WS_AY), (const bf16_t*)(ws + WS_WBRA), LDAY, LDAY, LDAY}; pg8::EpiMergeF E{GATE, MERGED}; pg8::gemm_phase(lds, g, S, E); } }
    SEAM(10);
    if (IN(11)) for (int rep_ = 0; rep_ < REP_11; ++rep_) { pg8::Gemm g{MERGED, (const bf16_t*)(ws + WS_WOUT), DM, DM, DM}; pg8::RectOrder S; S.init(ML / 256, DM / 256, G, bx); S.rep = UREP_11;
        pg8::EpiDelta<true> E{D1, D2, MOD, 5 * DM, 1.0f}; pg8::gemm_phase(lds, g, S, E); }
    SEAM(11);
    if (IN(12)) for (int rep_ = 0; rep_ < REP_12; ++rep_) norm_phase<false, true>(a.in[0], a.in[0], a.in[6] + 2 * DM, MOD, 6 * DM, 7 * DM, H, ML, wave, lane, nullptr, D2);
    SEAM(12);
    if (IN(13)) for (int rep_ = 0; rep_ < REP_13; ++rep_) { pg8::Gemm g{H, (const bf16_t*)(ws + WS_W2GU), DM, DM, DM}; pg8::RectOrder S; S.init(ML / 256, 2 * DFF / 256, G, bx); S.rep = UREP_13;
        pg8::EpiSwiGLU E{ACT}; pg8::gemm_phase(lds, g, S, E);
#ifdef PROBE_NULL
        { pg8::EpiNull E2{(float*)(ws + WS_S)}; pg8::gemm_phase(lds, g, S, E2); }
#endif
        }
    SEAM(13);
    if (IN(14)) for (int rep_ = 0; rep_ < REP_14; ++rep_) { pg8::Gemm g{ACT, (const bf16_t*)(ws + WS_W2D), DFF, DFF, DFF}; pg8::RectOrder S; S.init(ML / 256, DM / 256, G, bx);
        pg8::EpiFinal E{a.in[0], D2, a.out, MOD, 8 * DM, 0.5f}; pg8::gemm_phase(lds, g, S, E); }
#undef IN
#undef SEAM
}

extern "C" void kernel_launch(void* const* d_in, const int* in_sizes, int n_in, void* d_out, int out_size, void* d_ws, size_t ws_size, hipStream_t stream) {
    static int grid = 0;
    if (grid == 0) {
        if (n_in != 29 || out_size != ML * DM || ws_size < WS_END) { fprintf(stderr, "kernel_launch: unexpected shapes: n_in %d out %d ws %zu (need %zu)\n", n_in, out_size, ws_size, (size_t)WS_END); grid = -1; return; }
        int dev = 0, cus = 0, per_cu = 0;
        if (hipGetDevice(&dev) != hipSuccess || hipDeviceGetAttribute(&cus, hipDeviceAttributeMultiprocessorCount, dev) != hipSuccess) { fprintf(stderr, "kernel_launch: device query failed\n"); grid = -1; return; }
        const void* fn = (const void*)mega<(bool)MK_COOP>;
        if (hipFuncSetAttribute(fn, hipFuncAttributeMaxDynamicSharedMemorySize, LDS_BYTES) != hipSuccess) { fprintf(stderr, "kernel_launch: hipFuncSetAttribute failed\n"); grid = -1; return; }
        if (hipOccupancyMaxActiveBlocksPerMultiprocessor(&per_cu, fn, 512, LDS_BYTES) != hipSuccess || per_cu < 1) { fprintf(stderr, "kernel_launch: occupancy query says %d blocks/CU\n", per_cu); grid = -1; return; }
        grid = cus;
        if (grid > 256) grid = 256;
    }
    if (grid < 0) return;
    Args a{};
    for (int i = 0; i < 29; ++i) a.in[i] = (const float*)d_in[i];
    a.out = (float*)d_out; a.ws = (unsigned char*)d_ws;
#if MK_COOP
    a.ph_lo = 0; a.ph_hi = NPH;
    if (hipMemsetAsync((char*)d_ws + WS_BAR, 0, XCD_BAR_WORDS * 4, stream) != hipSuccess) { fprintf(stderr, "kernel_launch: memset failed\n"); return; }
    void* args[] = {&a};
    hipError_t e = hipLaunchCooperativeKernel((const void*)mega<true>, dim3(grid), dim3(512), args, LDS_BYTES, stream);
    if (e != hipSuccess) fprintf(stderr, "kernel_launch: cooperative launch failed: %s (grid %d)\n", hipGetErrorString(e), grid);
#else
    for (int k = 0; k < NPH; ++k) { a.ph_lo = k; a.ph_hi = k + 1; hipLaunchKernelGGL(mega<false>, dim3(grid), dim3(512), LDS_BYTES, stream, a); }
    hipError_t e = hipPeekAtLastError();
    if (e != hipSuccess) fprintf(stderr, "kernel_launch: launch failed: %s\n", hipGetErrorString(e));
#endif
}
```
